# Optimizing an MI355X kernel written in HIP

```python
import jax, jax.numpy as jnp
from jax import lax
import numpy as np

D_MODEL = 1024
BATCH = 8
SEQ = 4096
DEPTH = 1

D_MIX = D_MODEL
D_HGRN = D_MIX // 2
HGRN_HEAD_DIM = 128
HGRN_HEADS = D_HGRN // HGRN_HEAD_DIM
HGRN_CHUNK = 64
D_ATTN = D_MIX - D_HGRN
ATTN_HEAD_DIM = 64
ATTN_HEADS = D_ATTN // ATTN_HEAD_DIM
DILATED_PATTERNS = ((128, 1), (512, 4), (2048, 16))
D_IN_PROJ = 4 * D_HGRN + 3 * D_ATTN
N_EXPERTS = 32
TOP_K = 4
D_EXPERT = D_MODEL
SWIGLU_ALPHA = 1.702
SWIGLU_LIMIT = 7.0
MOE_BLOCK = 128
NORM_EPS = 1e-6

kernel_name = 'hymba_hgrn2_dilated_moe_block'


def _rmsnorm(x, g):
    xf = x.astype(jnp.float32)
    r = lax.rsqrt(jnp.mean(xf * xf, axis=-1, keepdims=True) + NORM_EPS)
    return (xf * r).astype(x.dtype) * g


def _head_rmsnorm(o, g, n_heads):
    B, S, W = o.shape
    of = o.astype(jnp.float32).reshape(B, S, n_heads, W // n_heads)
    of = of * lax.rsqrt(jnp.mean(of * of, axis=-1, keepdims=True) + NORM_EPS)
    return of.reshape(B, S, W).astype(o.dtype) * g


def _hgrn2(q, f_logit, v, lb):
    B, S, H, K = q.shape
    C = HGRN_CHUNK
    NC = S // C
    f = lb + (1.0 - lb) * jax.nn.sigmoid(f_logit)
    log_f = jnp.log(f)
    k = 1.0 - f

    def to_chunks(t):
        return t.reshape(B, NC, C, H, t.shape[-1]).transpose(1, 0, 3, 2, 4)

    causal = jnp.tril(jnp.ones((C, C), dtype=bool))

    def step(state, inp):
        qc, kc, vc, gc = inp
        b = jnp.cumsum(gc, axis=2)
        o_inter = jnp.einsum('bhtk,bhkv->bhtv', qc * jnp.exp(b), state)
        diff = b[:, :, :, None, :] - b[:, :, None, :, :]
        decay = jnp.exp(jnp.where(causal[:, :, None], diff, -jnp.inf))
        scores = jnp.einsum('bhtk,bhsk,bhtsk->bhts', qc, kc, decay)
        o_intra = jnp.einsum('bhts,bhsv->bhtv', scores, vc)
        b_last = b[:, :, -1:, :]
        new_state = (jnp.exp(b_last[:, :, 0, :])[..., None] * state
                     + jnp.einsum('bhsk,bhsv->bhkv', kc * jnp.exp(b_last - b), vc))
        return new_state, o_inter + o_intra

    V = v.shape[-1]
    s0 = jnp.zeros((B, H, K, V), jnp.float32)
    _, o = lax.scan(step, s0, (to_chunks(q), to_chunks(k), to_chunks(v), to_chunks(log_f)))
    return o.transpose(1, 0, 3, 2, 4).reshape(B, S, H * V)


def _dilated_pattern(q, k, v, window, dil):
    B, S, H, Dh = q.shape
    blk = window // dil
    span = dil * blk
    L = -(-S // span) * span
    M = L // dil
    nb = M // blk

    def to_classes(t):
        t = jnp.pad(t, ((0, 0), (0, L - S), (0, 0), (0, 0)))
        return t.reshape(B, M, dil, H, Dh).transpose(0, 2, 1, 3, 4).reshape(B, dil, nb, blk, H, Dh)

    def with_prev(t):
        prev = jnp.pad(t, ((0, 0), (0, 0), (1, 0), (0, 0), (0, 0), (0, 0)))[:, :, :-1]
        return jnp.concatenate([prev, t], axis=3)

    qc = to_classes(q)
    kw = with_prev(to_classes(k))
    vw = with_prev(to_classes(v))
    s = jnp.einsum('brnqhd,brnkhd->brnhqk', qc, kw) * (Dh ** -0.5)
    qi = jnp.arange(blk)[:, None]
    ki = jnp.arange(2 * blk)[None, :]
    dist = qi + blk - ki
    band = (dist >= 0) & (dist <= blk)
    has_prev = (jnp.arange(nb) > 0)[:, None, None] | (ki >= blk)[None]
    mask = band[None] & has_prev
    s = jnp.where(mask[None, None, :, None], s, -jnp.inf)
    m = jnp.max(s, axis=-1, keepdims=True)
    p = jnp.exp(s - m)
    den = jnp.sum(p, axis=-1)
    den_q = jnp.transpose(den, (0, 1, 2, 4, 3))
    o = jnp.einsum('brnhqk,brnkhd->brnqhd', p, vw) / den_q[..., None]
    lse = jnp.transpose(m[..., 0], (0, 1, 2, 4, 3)) + jnp.log(den_q)

    def from_classes(t):
        t = t.reshape((B, dil, M) + t.shape[4:])
        t = jnp.moveaxis(t, 1, 2)
        return t.reshape((B, L) + t.shape[3:])[:, :S]

    return from_classes(o), from_classes(lse)


def _dilated_mixture(q, k, v):
    outs = []
    lses = []
    for window, dil in DILATED_PATTERNS:
        o_p, lse_p = _dilated_pattern(q, k, v, window, dil)
        outs.append(o_p)
        lses.append(lse_p)
    wts = jax.nn.softmax(jnp.stack(lses, axis=0), axis=0)
    return jnp.sum(jnp.stack(outs, axis=0) * wts[..., None], axis=0)


def _clamped_swiglu(u):
    glu = jnp.minimum(u[..., ::2], SWIGLU_LIMIT)
    lin = jnp.clip(u[..., 1::2], -SWIGLU_LIMIT, SWIGLU_LIMIT)
    return glu * jax.nn.sigmoid(SWIGLU_ALPHA * glu) * (lin + 1.0)


def _moe(h, router_w, router_b, w_up, b_up, w_down, b_down):
    N, D = h.shape
    NK = N * TOP_K
    logits = (h @ router_w + router_b).astype(jnp.float32)
    top_vals, top_idx = lax.top_k(logits, TOP_K)
    gates = jax.nn.softmax(top_vals, axis=-1)
    flat_e = top_idx.reshape(-1)
    flat_tok = jnp.arange(NK, dtype=jnp.int32) // TOP_K
    order = jnp.argsort(flat_e)
    sorted_e = flat_e[order]
    sorted_tok = flat_tok[order]
    counts = jnp.bincount(flat_e, length=N_EXPERTS)
    padded = (counts + MOE_BLOCK - 1) // MOE_BLOCK * MOE_BLOCK
    pad_end = jnp.cumsum(padded)
    pad_start = pad_end - padded
    start = jnp.cumsum(counts) - counts
    dest = pad_start[sorted_e] + jnp.arange(NK, dtype=jnp.int32) - start[sorted_e]
    R = NK + N_EXPERTS * MOE_BLOCK
    NB = R // MOE_BLOCK
    xbuf = jnp.zeros((R, D), h.dtype).at[dest].set(h[sorted_tok])
    block_e = jnp.clip(jnp.searchsorted(pad_end, jnp.arange(NB) * MOE_BLOCK, side='right'),
                       0, N_EXPERTS - 1)

    def expert_block(args):
        xb, e = args
        u = xb @ w_up[e] + b_up[e]
        return _clamped_swiglu(u) @ w_down[e] + b_down[e]

    ybuf = lax.map(expert_block, (xbuf.reshape(NB, MOE_BLOCK, D), block_e)).reshape(R, D)
    y = ybuf[dest] * gates.reshape(-1)[order][:, None].astype(ybuf.dtype)
    return jnp.zeros((N, D), h.dtype).at[sorted_tok].add(y)


def setup_inputs(seed: int = 0) -> dict:
    key = jax.random.key(seed)
    ks = jax.random.split(key, 16)
    f32 = jnp.float32
    nrm = lambda k, shape, scale: jax.random.normal(k, shape, f32) * scale
    return {
        'x': jax.random.normal(ks[0], (BATCH, SEQ, D_MODEL), f32),
        'norm1_g': 1.0 + nrm(ks[1], (DEPTH, D_MODEL), 0.02),
        'w_in': nrm(ks[2], (DEPTH, D_MODEL, D_IN_PROJ), D_MODEL ** -0.5),
        'hgrn_lb_logits': nrm(ks[3], (DEPTH + 1, D_HGRN), 0.5),
        'hgrn_norm_g': 1.0 + nrm(ks[4], (DEPTH, D_HGRN), 0.02),
        'attn_norm_g': 1.0 + nrm(ks[5], (DEPTH, D_ATTN), 0.02),
        'w_out': nrm(ks[6], (DEPTH, D_MIX, D_MODEL), D_MIX ** -0.5),
        'norm2_g': 1.0 + nrm(ks[7], (DEPTH, D_MODEL), 0.02),
        'router_w': nrm(ks[8], (DEPTH, D_MODEL, N_EXPERTS), D_MODEL ** -0.5),
        'router_b': nrm(ks[9], (DEPTH, N_EXPERTS), 0.01),
        'w_up': nrm(ks[10], (DEPTH, N_EXPERTS, D_MODEL, 2 * D_EXPERT), D_MODEL ** -0.5),
        'b_up': nrm(ks[11], (DEPTH, N_EXPERTS, 2 * D_EXPERT), 0.01),
        'w_down': nrm(ks[12], (DEPTH, N_EXPERTS, D_EXPERT, D_MODEL), D_EXPERT ** -0.5),
        'b_down': nrm(ks[13], (DEPTH, N_EXPERTS, D_MODEL), 0.01),
        'final_norm_g': 1.0 + nrm(ks[14], (D_MODEL,), 0.02),
    }


def reference(x, norm1_g, w_in, hgrn_lb_logits, hgrn_norm_g, attn_norm_g, w_out, norm2_g,
              router_w, router_b, w_up, b_up, w_down, b_down, final_norm_g):
    B, S, D = x.shape
    f32 = jnp.float32
    lb_all = jnp.cumsum(jax.nn.softmax(hgrn_lb_logits.astype(f32), axis=0), axis=0)
    splits = [D_HGRN, 2 * D_HGRN, 3 * D_HGRN, 4 * D_HGRN, 4 * D_HGRN + D_ATTN, 4 * D_HGRN + 2 * D_ATTN]
    for l in range(DEPTH):
        h = _rmsnorm(x, norm1_g[l])
        proj = h @ w_in[l]
        hq, hf, hi, hg, aq, ak, av = jnp.split(proj, splits, axis=-1)
        lb = lb_all[l].reshape(HGRN_HEADS, HGRN_HEAD_DIM)
        to_h = lambda t: t.astype(f32).reshape(B, S, HGRN_HEADS, HGRN_HEAD_DIM)
        o_a = _hgrn2(to_h(hq), to_h(hf), to_h(hi), lb).astype(x.dtype)
        o_a = _head_rmsnorm(o_a, hgrn_norm_g[l], HGRN_HEADS) * jax.nn.silu(hg)
        to_a = lambda t: t.astype(f32).reshape(B, S, ATTN_HEADS, ATTN_HEAD_DIM)
        o_b = _dilated_mixture(to_a(aq), to_a(ak), to_a(av)).reshape(B, S, D_ATTN).astype(x.dtype)
        o_b = _head_rmsnorm(o_b, attn_norm_g[l], ATTN_HEADS)
        x = x + jnp.concatenate([o_a, o_b], axis=-1) @ w_out[l]
        h2 = _rmsnorm(x, norm2_g[l]).reshape(B * S, D)
        x = x + _moe(h2, router_w[l], router_b[l], w_up[l], b_up[l], w_down[l], b_down[l]).reshape(B, S, D)
    return _rmsnorm(x, final_norm_g)
```

```cpp
#include <hip/hip_runtime.h>
#include <cstdio>
#include <cstdint>

#ifndef PROBE_SKIP
#define PROBE_SKIP 0
#endif
#ifndef MOE_FP8
#define MOE_FP8 1
#endif
#ifndef MK_N_LAUNCHES
#define MK_N_LAUNCHES 1
#endif

#define GAS __attribute__((address_space(1)))
#define LAS __attribute__((address_space(3)))
typedef unsigned short bf16;
typedef unsigned v4u __attribute__((ext_vector_type(4)));
typedef unsigned v2u __attribute__((ext_vector_type(2)));
typedef float f32x4 __attribute__((ext_vector_type(4)));
typedef short bf16x8 __attribute__((ext_vector_type(8)));
typedef int v4i __attribute__((ext_vector_type(4)));
typedef int v8i __attribute__((ext_vector_type(8)));

constexpr int NT = 32768, DM = 1024, SEQ = 4096, NBATCH = 8;
constexpr int DH = 512;
constexpr int DPROJ = 3584;
constexpr int C_HQ = 0, C_HF = 512, C_HI = 1024, C_HG = 1536, C_AQ = 2048, C_AK = 2560, C_AV = 3072;
constexpr int NE = 32, DUP = 2048, DEXP = 1024;
constexpr float EPS = 1e-6f;
constexpr int NPHASE = 10;
constexpr int NWAVES = 8, NTHR = 512;
constexpr int RMAX = NT * 4 + NE * 256;

constexpr size_t MiB = 1u << 20;
constexpr size_t WS_CTL = 0, CTL_ZERO_BYTES = 1 * MiB;
constexpr size_t WS_WIN = 1 * MiB;
constexpr size_t WS_WOUT = 8 * MiB;
constexpr size_t WS_WUP = 10 * MiB;
constexpr size_t WS_WDN = 138 * MiB;
constexpr size_t WS_XN = 202 * MiB;
constexpr size_t WS_OA = WS_XN;
constexpr size_t WS_QPP = WS_XN + 32 * MiB;
constexpr size_t WS_MIX = 266 * MiB;
constexpr size_t WS_PROJ = 330 * MiB;
constexpr size_t WS_OP = 554 * MiB;
constexpr size_t WS_ACT = 330 * MiB;
constexpr size_t WS_XBUF = 466 * MiB;
constexpr size_t WS_SMALL = 650 * MiB;
constexpr size_t WS_TOPI = WS_SMALL;
constexpr size_t WS_GATE = WS_SMALL + 1 * MiB;
constexpr size_t WS_DEST = WS_SMALL + 2 * MiB;
constexpr size_t WS_ROWTOK = WS_SMALL + 3 * MiB;
constexpr size_t WS_BC = WS_SMALL + 4 * MiB;
constexpr size_t WS_CNT = WS_SMALL + 5 * MiB;
constexpr size_t WS_YBUF = 658 * MiB;
constexpr size_t WS_LSE = WS_YBUF;
constexpr size_t WS_SEGS = WS_YBUF + 4 * MiB;
constexpr size_t WS_SEGD = WS_YBUF + 20 * MiB;
constexpr size_t WS_KV = 930 * MiB;
constexpr size_t WS_QH = WS_YBUF + 22 * MiB;
constexpr size_t WS_END = 994 * MiB;

constexpr int CW_BAR = 4096;

constexpr int LDS_BYTES = 147456;
constexpr int MISC_OFF = 131072 + 8192;

#define RLX_AGENT __ATOMIC_RELAXED, __HIP_MEMORY_SCOPE_AGENT
__device__ __forceinline__ unsigned f2bf(float f) { unsigned u = __builtin_bit_cast(unsigned, f); return (u + 0x7fffu + ((u >> 16) & 1u)) >> 16; }
__device__ __forceinline__ unsigned pk2(float lo, float hi) { return f2bf(lo) | (f2bf(hi) << 16); }
__device__ __forceinline__ unsigned pk4_fp8(float a, float b, float c, float d) { int w = 0; w = __builtin_amdgcn_cvt_pk_fp8_f32(a, b, w, false); w = __builtin_amdgcn_cvt_pk_fp8_f32(c, d, w, true); return (unsigned)w; }
constexpr float FP8_WSCALE = 64.0f, FP8_WINV = 1.0f / 64.0f;
__device__ __forceinline__ float bf2f(unsigned h) { return __builtin_bit_cast(float, h << 16); }
__device__ __forceinline__ float bflo(unsigned w) { return __builtin_bit_cast(float, w << 16); }
__device__ __forceinline__ float bfhi(unsigned w) { return __builtin_bit_cast(float, w & 0xffff0000u); }
#define RL(x, i) __builtin_bit_cast(float, __builtin_amdgcn_readlane(__builtin_bit_cast(int, (x)), (i)))
__device__ __forceinline__ float wave_sum(float v) {
#pragma unroll
    for (int o = 1; o < 64; o <<= 1) v += __shfl_xor(v, o);
    return v;
}
__device__ __forceinline__ float wave_max(float v) {
#pragma unroll
    for (int o = 1; o < 64; o <<= 1) v = fmaxf(v, __shfl_xor(v, o));
    return v;
}

#define XB_TMO      128
#define XB_XCNT(j)  (256  + 64 * (j))
#define XB_XSUB(j)  (1280 + 64 * (j))
#define XB_XGEN(j)  (2304 + 64 * (j))
#define XB_TOP      3328
#define XB_TOPGEN   3392
#define XCD_BAR_WORDS 3456
#define XB_SPIN_CAP (1u << 22)
__device__ __forceinline__ unsigned xb_ld(unsigned* p)              { return __hip_atomic_load(p, __ATOMIC_RELAXED, __HIP_MEMORY_SCOPE_AGENT); }
__device__ __forceinline__ unsigned xb_add(unsigned* p, unsigned v) { return __hip_atomic_fetch_add(p, v, __ATOMIC_RELAXED, __HIP_MEMORY_SCOPE_AGENT); }
__device__ __forceinline__ unsigned xb_xcc_id() { return (unsigned)__builtin_amdgcn_s_getreg((3 << 11) | 20) & 0xFu; }
#define XB_SPIN(cond, bar) do { unsigned _sp = 0; while (cond) { __builtin_amdgcn_s_sleep(1); \
    if ((++_sp & 255u) == 0u) { if (xb_ld(&(bar)[XB_TMO])) break; if (_sp > XB_SPIN_CAP) { atomicAdd(&(bar)[XB_TMO], 1u); break; } } } } while (0)
struct XcdBarrier { unsigned* bar; unsigned x; volatile LAS unsigned* st; };
__device__ __forceinline__ XcdBarrier xcd_barrier_post(unsigned* bar, volatile LAS unsigned* st) {
    XcdBarrier b; b.bar = bar; b.x = xb_xcc_id(); b.st = st;
    if (threadIdx.x == 0) (void)xb_add(&bar[XB_XCNT(b.x)], 1u);
    return b;
}
__device__ __forceinline__ void xcd_barrier_complete(unsigned* bar, unsigned x, unsigned& nloc, unsigned& nx) {
    const unsigned G = gridDim.x * gridDim.y * gridDim.z;
    unsigned sum, cnt, mine, sp = 0u;
    for (;;) {
        sum = 0u; cnt = 0u; mine = 0u;
#pragma unroll
        for (unsigned j = 0; j < 16; ++j) { const unsigned c = xb_ld(&bar[XB_XCNT(j)]); sum += c; cnt += (c > 0u) ? 1u : 0u; mine = (j == x) ? c : mine; }
        if (sum == G) break;
        __builtin_amdgcn_s_sleep(1);
        if ((++sp & 255u) == 0u) { if (xb_ld(&bar[XB_TMO])) break; if (sp > XB_SPIN_CAP) { atomicAdd(&bar[XB_TMO], 1u); break; } }
    }
    nloc = mine > 0u ? mine : 1u; nx = cnt > 0u ? cnt : 1u;
}
__device__ __forceinline__ void xcd_barrier(const XcdBarrier& b) {
    asm volatile("s_waitcnt vmcnt(0)" ::: "memory");
    __syncthreads();
    if (threadIdx.x == 0) {
        unsigned* bar = b.bar;
        __builtin_amdgcn_s_waitcnt(0);
        unsigned nloc = b.st[0], nx = b.st[1];
        if (nloc == 0u) { xcd_barrier_complete(bar, b.x, nloc, nx); b.st[0] = nloc; b.st[1] = nx; }
        const unsigned old = xb_add(&bar[XB_XSUB(b.x)], 1u);
        const unsigned gen = old / nloc;
        if (old + 1u == (gen + 1u) * nloc) {
            __builtin_amdgcn_fence(__ATOMIC_RELEASE, "agent");
            asm volatile("s_waitcnt vmcnt(0)" ::: "memory");
            const unsigned og = xb_add(&bar[XB_TOP], 1u);
            const unsigned tg = og / nx;
            if (og + 1u == (tg + 1u) * nx) xb_add(&bar[XB_TOPGEN], 1u);
            else XB_SPIN(xb_ld(&bar[XB_TOPGEN]) == tg, bar);
            __builtin_amdgcn_fence(__ATOMIC_ACQUIRE, "agent");
            xb_add(&bar[XB_XGEN(b.x)], 1u);
            asm volatile("s_waitcnt vmcnt(0)" ::: "memory");
        } else {
            XB_SPIN(xb_ld(&bar[XB_XGEN(b.x)]) == gen, bar);
            __builtin_amdgcn_fence(__ATOMIC_ACQUIRE, "agent");
            asm volatile("s_waitcnt vmcnt(0)" ::: "memory");
        }
    }
    __syncthreads();
}

struct Args {
    const float* x; const float* norm1_g; const float* w_in; const float* lb_logits; const float* hgrn_g; const float* attn_g; const float* w_out;
    const float* norm2_g; const float* router_w; const float* router_b; const float* w_up; const float* b_up; const float* w_down; const float* b_down; const float* final_g;
    float* out; unsigned char* ws; int ph_lo, ph_hi, li, pad;
};

struct Frame { LAS unsigned char* lds; int tid, lane, wave, G, bid; };

__device__ __forceinline__ void p0_transpose_item(const float* W, int K, int N, bf16* WT, LAS float* scr, int item, int lane) {
    const int nblk = N / 32, kb = item / nblk, nb = item % nblk, k0 = 64 * kb, n0 = 32 * nb;
#pragma unroll 8
    for (int i = 0; i < 32; ++i) { const int kk = 2 * i + (lane >> 5); scr[kk * 33 + (lane & 31)] = W[(size_t)(k0 + kk) * N + n0 + (lane & 31)]; }
    asm volatile("s_waitcnt lgkmcnt(0)" ::: "memory");
    const int c = lane & 7;
#pragma unroll
    for (int j = 0; j < 4; ++j) { const int n = (lane >> 3) + 8 * j; const LAS float* s = scr + (8 * c) * 33 + n;
        v4u o; o.x = pk2(s[0 * 33], s[1 * 33]); o.y = pk2(s[2 * 33], s[3 * 33]); o.z = pk2(s[4 * 33], s[5 * 33]); o.w = pk2(s[6 * 33], s[7 * 33]);
        *(v4u*)(WT + (size_t)(n0 + n) * K + k0 + 8 * c) = o; }
    asm volatile("s_waitcnt lgkmcnt(0)" ::: "memory");
}
__device__ __forceinline__ void p0_transpose_item_fp8(const float* W, int K, int N, unsigned char* WT, LAS float* scr, int item, int lane, float sc) {
    const int nblk = N / 32, kb = item / nblk, nb = item % nblk, k0 = 64 * kb, n0 = 32 * nb;
#pragma unroll 8
    for (int i = 0; i < 32; ++i) { const int kk = 2 * i + (lane >> 5); scr[kk * 33 + (lane & 31)] = W[(size_t)(k0 + kk) * N + n0 + (lane & 31)]; }
    asm volatile("s_waitcnt lgkmcnt(0)" ::: "memory");
    const int c = lane & 7;
#pragma unroll
    for (int j = 0; j < 4; ++j) { const int n = (lane >> 3) + 8 * j; const LAS float* sp = scr + (8 * c) * 33 + n;
        v2u o; o.x = pk4_fp8(sp[0 * 33] * sc, sp[1 * 33] * sc, sp[2 * 33] * sc, sp[3 * 33] * sc); o.y = pk4_fp8(sp[4 * 33] * sc, sp[5 * 33] * sc, sp[6 * 33] * sc, sp[7 * 33] * sc);
        *(v2u*)(WT + (size_t)(n0 + n) * K + k0 + 8 * c) = o; }
    asm volatile("s_waitcnt lgkmcnt(0)" ::: "memory");
}
__device__ __forceinline__ void phase0(const Args& a, const Frame& F) {
    LAS float* scr = (LAS float*)(F.lds + F.wave * 16384);
    const int gw = F.bid * NWAVES + F.wave, NGW = F.G * NWAVES;
    constexpr int I_IN = (DM / 64) * (DPROJ / 32), I_OUT = (DM / 64) * (DM / 32), I_UP1 = (DM / 64) * (DUP / 32), I_DN1 = (DEXP / 64) * (DM / 32);
    constexpr int NITEMS = I_IN + I_OUT + NE * I_UP1 + NE * I_DN1;
    bf16* win = (bf16*)(a.ws + WS_WIN); bf16* wout = (bf16*)(a.ws + WS_WOUT); bf16* wup = (bf16*)(a.ws + WS_WUP); bf16* wdn = (bf16*)(a.ws + WS_WDN);
    for (int it = gw; it < NITEMS; it += NGW) {
        int r = it;
        if (r < I_IN) { p0_transpose_item(a.w_in, DM, DPROJ, win, scr, r, F.lane); continue; } r -= I_IN;
        if (r < I_OUT) { p0_transpose_item(a.w_out, DM, DM, wout, scr, r, F.lane); continue; } r -= I_OUT;
        if (r < NE * I_UP1) { const int e = r / I_UP1;
            if (MOE_FP8) p0_transpose_item_fp8(a.w_up + (size_t)e * DM * DUP, DM, DUP, (unsigned char*)wup + (size_t)e * DUP * DM, scr, r % I_UP1, F.lane, FP8_WSCALE);
            else p0_transpose_item(a.w_up + (size_t)e * DM * DUP, DM, DUP, wup + (size_t)e * DUP * DM, scr, r % I_UP1, F.lane); continue; } r -= NE * I_UP1;
        { const int e = r / I_DN1;
            if (MOE_FP8) p0_transpose_item_fp8(a.w_down + (size_t)e * DEXP * DM, DEXP, DM, (unsigned char*)wdn + (size_t)e * DM * DEXP, scr, r % I_DN1, F.lane, FP8_WSCALE);
            else p0_transpose_item(a.w_down + (size_t)e * DEXP * DM, DEXP, DM, wdn + (size_t)e * DM * DEXP, scr, r % I_DN1, F.lane); }
    }
    bf16* xn = (bf16*)(a.ws + WS_XN);
    for (int m = gw; m < NT; m += NGW) {
        const f32x4* xr = (const f32x4*)(a.x + (size_t)m * DM) + F.lane;
        const f32x4* gr = (const f32x4*)a.norm1_g + F.lane;
        f32x4 v[4]; float s = 0.f;
#pragma unroll
        for (int j = 0; j < 4; ++j) { v[j] = xr[64 * j]; s += (v[j].x * v[j].x + v[j].y * v[j].y) + (v[j].z * v[j].z + v[j].w * v[j].w); }
        const float r = 1.0f / sqrtf(wave_sum(s) * (1.f / DM) + EPS);
        v2u* o8 = (v2u*)(xn + (size_t)m * DM) + F.lane;
#pragma unroll
        for (int j = 0; j < 4; ++j) { const f32x4 g = gr[64 * j]; v2u w; w.x = pk2(v[j].x * r * g.x, v[j].y * r * g.y); w.y = pk2(v[j].z * r * g.z, v[j].w * r * g.w); o8[64 * j] = w; }
    }
}

template <class RowPtr, class Epi>
__device__ __forceinline__ void gemm_unit_simple(const RowPtr& rp, const bf16* Bt, int K, const Epi& epi, int wave, int lane) {
    const int fr = lane & 15, fq = lane >> 4, wm = wave & 3, wn = wave >> 2;
    const bf16* ap[4]; const bf16* bp[4];
#pragma unroll
    for (int i = 0; i < 4; ++i) { ap[i] = rp(wm * 64 + i * 16 + fr) + fq * 8; bp[i] = Bt + (size_t)(wn * 64 + i * 16 + fr) * K + fq * 8; }
    f32x4 acc[4][4];
#pragma unroll
    for (int i = 0; i < 4; ++i)
#pragma unroll
        for (int j = 0; j < 4; ++j) acc[i][j] = (f32x4){0.f, 0.f, 0.f, 0.f};
    for (int k0 = 0; k0 < K; k0 += 32) {
        bf16x8 af[4], bfr[4];
#pragma unroll
        for (int i = 0; i < 4; ++i) { af[i] = *(const bf16x8*)(ap[i] + k0); bfr[i] = *(const bf16x8*)(bp[i] + k0); }
#pragma unroll
        for (int i = 0; i < 4; ++i)
#pragma unroll
            for (int j = 0; j < 4; ++j) acc[i][j] = __builtin_amdgcn_mfma_f32_16x16x32_bf16(bfr[j], af[i], acc[i][j], 0, 0, 0);
    }
#pragma unroll
    for (int i = 0; i < 4; ++i)
#pragma unroll
        for (int j = 0; j < 4; ++j) epi(wm * 64 + i * 16 + fr, wn * 64 + j * 16 + fq * 4, acc[i][j]);
}

namespace pg8 {
constexpr int BM = 256, BK = 64, HALF = 128, HTB = HALF * BK * 2, STAGE_BYTES = 8 * HTB, NXCD = 8, WGM = 8;
__device__ __forceinline__ int lds_byte(int r, int c) { const int st = (r >> 4) * 2 + (c >> 5), rr = r & 15, cc = c & 31, ob = rr * 64 + cc * 2; return st * 1024 + (ob ^ (((ob >> 9) & 1) << 5)); }
__device__ __forceinline__ void stage_rc(int b, int& R, int& C) { const int st = b / 1024, sb = b % 1024, swz = sb ^ (((sb >> 9) & 1) << 5); R = (st >> 1) * 16 + swz / 64; C = (st & 1) * 32 + (swz % 64) / 2; }
__device__ __forceinline__ int perm32(int rho) { const int n = rho >> 4, i = rho & 15; return 8 * (i >> 2) + 4 * n + (i & 3); }
struct Unit { int pm, pn; };
__device__ __forceinline__ bool order_next(int nM, int nN, int G, int c, int i, Unit& u) {
    const int nwg = nM * nN; const long L = (long)i * G + c; if (L >= nwg) return false;
    int wgid = (int)L; { const int q = nwg / NXCD, r = nwg % NXCD, xcd = wgid % NXCD, off = wgid / NXCD; wgid = (xcd < r ? xcd * (q + 1) : r * (q + 1) + (xcd - r) * q) + off; }
    const int nig = WGM * nN, gid = wgid / nig, fm = gid * WGM, gsz = (nM - fm) < WGM ? (nM - fm) : WGM;
    u.pm = fm + ((wgid % nig) % gsz); u.pn = (wgid % nig) / gsz; return true;
}
__device__ __forceinline__ unsigned cvt_pk_bf16(float lo, float hi) { unsigned r; asm volatile("v_cvt_pk_bf16_f32 %0, %1, %2" : "=v"(r) : "v"(lo), "v"(hi)); return r; }

template <class Epi, class Sched, bool ALIGN_EPI, bool FP8 = false>
__device__ __forceinline__ void gemm_phase(LAS unsigned char* lds, const int KB, const Sched& S, const Epi& E, const unsigned char* wsb) {
    const __amdgpu_buffer_rsrc_t rs = __builtin_amdgcn_make_buffer_rsrc((void*)wsb, 0, -1, 0x00020000);
    const int tid = threadIdx.x, wid = __builtin_amdgcn_readfirstlane(tid >> 6), lane = tid & 63, wr = wid >> 2, wc = wid & 3, fr = lane & 15, fq = lane >> 4;
    const int nt = KB / (BK * 2);
    unsigned voffB[2];
#pragma unroll
    for (int i = 0; i < 2; ++i) { int R, C; stage_rc(tid * 16 + i * 8192, R, C); const int Rb = Epi::PERM ? (64 * (R >> 5) + 16 * ((R & 15) >> 2) + 4 * ((R >> 4) & 1) + (R & 3)) : R; voffB[i] = (unsigned)(Rb * KB + C * 2); }
#define PG8_RC(Rr, Cc) int Rr[2], Cc[2]; { int tl_ = tid; asm volatile("" : "+v"(tl_)); _Pragma("unroll") for (int i_ = 0; i_ < 2; ++i_) stage_rc(tl_ * 16 + i_ * 8192, Rr[i_], Cc[i_]); }
    const unsigned kstep = (unsigned)(BK * 2);
    const unsigned hstep = (unsigned)HALF * (unsigned)KB;
    const unsigned bh = Epi::PERM ? 8u * (unsigned)KB : hstep;
    const unsigned ldsw = (unsigned)wid * 1024u;
    const int aoff = lds_byte(wr * 64 + fr, fq * 8), boff = lds_byte(wc * 32 + fr, fq * 8);
#define PG8_SA(b, h) (((b) * 2 + (h)) * HTB)
#define PG8_SB(b, h) ((4 + (b) * 2 + (h)) * HTB)
#define PG8_STAGE(bufoff, gbase, v0, v1) do { \
        __builtin_amdgcn_raw_ptr_buffer_load_lds(rs, (LAS void*)(lds + (bufoff) + ldsw), 16, (int)(v0), (int)(gbase), 0, 0); \
        __builtin_amdgcn_raw_ptr_buffer_load_lds(rs, (LAS void*)(lds + (bufoff) + ldsw + 8192), 16, (int)(v1), (int)(gbase), 0, 0); } while (0)
#define PG8_STAGEB(bufoff, gbase) PG8_STAGE(bufoff, gbase, voffB[0], voffB[1])
#define PG8_LDA(dst, b, h) do { _Pragma("unroll") for (int m = 0; m < 4; ++m) _Pragma("unroll") for (int k = 0; k < 2; ++k) dst[m][k] = *(const LAS bf16x8*)(lds + PG8_SA(b, h) + aoff + m * 2048 + k * 1024); } while (0)
#define PG8_LDB(dst, b, h) do { _Pragma("unroll") for (int n = 0; n < 2; ++n) _Pragma("unroll") for (int k = 0; k < 2; ++k) dst[n][k] = *(const LAS bf16x8*)(lds + PG8_SB(b, h) + boff + n * 2048 + k * 1024); } while (0)
#define PG8_CAT(x) __builtin_shufflevector(__builtin_bit_cast(v4i, (x)[0]), __builtin_bit_cast(v4i, (x)[1]), 0, 1, 2, 3, 4, 5, 6, 7)
#define PG8_MMA(ai, bj, At, Bt) do { __builtin_amdgcn_s_setprio(1); \
        if constexpr (FP8) { _Pragma("unroll") for (int m = 0; m < 4; ++m) _Pragma("unroll") for (int n = 0; n < 2; ++n) \
            acc[ai][bj][m][n] = __builtin_amdgcn_mfma_scale_f32_16x16x128_f8f6f4(PG8_CAT(Bt[n]), PG8_CAT(At[m]), acc[ai][bj][m][n], 0, 0, 0, 0x7f7f7f7f, 0, 0x7f7f7f7f); } \
        else { _Pragma("unroll") for (int m = 0; m < 4; ++m) _Pragma("unroll") for (int n = 0; n < 2; ++n) _Pragma("unroll") for (int k = 0; k < 2; ++k) \
            acc[ai][bj][m][n] = __builtin_amdgcn_mfma_f32_16x16x32_bf16(Bt[n][k], At[m][k], acc[ai][bj][m][n], 0, 0, 0); } __builtin_amdgcn_s_setprio(0); } while (0)
#define PG8_WAIT_V(n) asm volatile("s_waitcnt vmcnt(" #n ")" ::: "memory")
#define PG8_WAIT_L(n) asm volatile("s_waitcnt lgkmcnt(" #n ")" ::: "memory")
#define PG8_BAR __builtin_amdgcn_s_barrier()
#define PG8_SCHED __builtin_amdgcn_sched_barrier(0)
    Unit cur, nxt; int ui = 0;
    if (!S.next(0, cur)) return;
    unsigned vA[2][2], vN[2][2];
    { PG8_RC(Rr, Cc) S.offsets(cur, Rr, Cc, vA); }
    bool has_next = S.next(1, nxt);
    if (Sched::GATHER) { if (has_next) { PG8_RC(Rr, Cc) S.offsets(nxt, Rr, Cc, vN); } else { vN[0][0] = vA[0][0]; vN[0][1] = vA[0][1]; vN[1][0] = vA[1][0]; vN[1][1] = vA[1][1]; } }
    f32x4 acc[2][2][4][2];
#pragma unroll
    for (int a = 0; a < 2; ++a)
#pragma unroll
        for (int b = 0; b < 2; ++b)
#pragma unroll
            for (int m = 0; m < 4; ++m)
#pragma unroll
                for (int n = 0; n < 2; ++n) acc[a][b][m][n] = (f32x4){0.f, 0.f, 0.f, 0.f};
    bf16x8 At[4][2], B0[2][2], B1[2][2];
    unsigned cA = (unsigned)(S.a_base(cur) - (const char*)wsb), cB = (unsigned)(S.b_base(cur) - (const char*)wsb);
    PG8_STAGEB(PG8_SB(0, 0), cB); PG8_STAGEB(PG8_SB(0, 1), cB + bh); PG8_STAGE(PG8_SA(0, 0), cA, vA[0][0], vA[0][1]); PG8_STAGE(PG8_SA(0, 1), cA, vA[1][0], vA[1][1]);
    if (wr == 1) PG8_BAR;
    PG8_WAIT_V(2); PG8_BAR;
    PG8_STAGEB(PG8_SB(1, 0), cB + kstep); PG8_STAGE(PG8_SA(1, 0), cA + kstep, vA[0][0], vA[0][1]); PG8_STAGEB(PG8_SB(1, 1), cB + bh + kstep);
    PG8_WAIT_V(6); PG8_BAR;
    for (;;) {
        const unsigned nA = has_next ? (unsigned)(S.a_base(nxt) - (const char*)wsb) : cA, nB = has_next ? (unsigned)(S.b_base(nxt) - (const char*)wsb) : cB;
#pragma unroll 1
        for (int t = 0; t < nt; t += 2) {
            const bool last = (t == nt - 2);
            if constexpr (FP8) { asm volatile("" : "+v"(vA[0][0]), "+v"(vA[0][1]), "+v"(vA[1][0]), "+v"(vA[1][1]), "+v"(voffB[0]), "+v"(voffB[1])); }
            const unsigned a1 = cA + (unsigned)(t + 1) * kstep;
            const unsigned a2 = last ? nA : cA + (unsigned)(t + 2) * kstep, b2 = last ? nB : cB + (unsigned)(t + 2) * kstep;
            const unsigned a3 = a2 + kstep, b3 = b2 + kstep;
            unsigned w00, w01, w10, w11;
            if (Sched::GATHER) { const bool sw = last && has_next; w00 = sw ? vN[0][0] : vA[0][0]; w01 = sw ? vN[0][1] : vA[0][1]; w10 = sw ? vN[1][0] : vA[1][0]; w11 = sw ? vN[1][1] : vA[1][1]; }
            else { w00 = vA[0][0]; w01 = vA[0][1]; w10 = vA[1][0]; w11 = vA[1][1]; }
            PG8_LDB(B0, 0, 0); PG8_LDB(B1, 0, 1); PG8_SCHED; PG8_LDA(At, 0, 0); PG8_STAGE(PG8_SA(1, 1), a1, vA[1][0], vA[1][1]);
            PG8_WAIT_V(8); PG8_WAIT_L(0); PG8_BAR; PG8_MMA(0, 0, At, B0); PG8_MMA(0, 1, At, B1); PG8_BAR; PG8_SCHED;
            PG8_LDA(At, 0, 1); PG8_STAGEB(PG8_SB(0, 0), b2); PG8_STAGEB(PG8_SB(0, 1), b2 + bh); PG8_STAGE(PG8_SA(0, 0), a2, w00, w01);
            PG8_WAIT_V(8); PG8_WAIT_L(0); PG8_BAR; PG8_MMA(1, 0, At, B0); PG8_MMA(1, 1, At, B1); PG8_BAR; PG8_SCHED;
            PG8_LDB(B0, 1, 0); PG8_LDB(B1, 1, 1); PG8_SCHED; PG8_LDA(At, 1, 0); PG8_STAGE(PG8_SA(0, 1), a2, w10, w11);
            PG8_WAIT_V(8); PG8_WAIT_L(0); PG8_BAR; PG8_MMA(0, 0, At, B0); PG8_MMA(0, 1, At, B1); PG8_BAR; PG8_SCHED;
            PG8_LDA(At, 1, 1); PG8_STAGEB(PG8_SB(1, 0), b3); PG8_STAGEB(PG8_SB(1, 1), b3 + bh); PG8_STAGE(PG8_SA(1, 0), a3, w00, w01);
            PG8_WAIT_V(8); PG8_WAIT_L(0); PG8_BAR; PG8_MMA(1, 0, At, B0); PG8_MMA(1, 1, At, B1); PG8_BAR; PG8_SCHED;
        }
        if constexpr (ALIGN_EPI) { if (wr == 0) PG8_BAR; }
        unsigned vT[2][2];
        Unit n2; bool has_n2 = false;
        if (Sched::GATHER) { has_n2 = has_next && S.next(ui + 2, n2); if (has_n2) { PG8_RC(Rr, Cc) S.tokens(n2, Rr, vT); } }
        E(acc, cur, wr, wc, fr, fq);
        if (!has_next) break;
#pragma unroll
        for (int a = 0; a < 2; ++a)
#pragma unroll
            for (int b = 0; b < 2; ++b)
#pragma unroll
                for (int m = 0; m < 4; ++m)
#pragma unroll
                    for (int n = 0; n < 2; ++n) acc[a][b][m][n] = (f32x4){0.f, 0.f, 0.f, 0.f};
        cur = nxt; cA = nA; cB = nB; ++ui;
        if (Sched::GATHER) { PG8_RC(Rr, Cc)
#pragma unroll
            for (int h = 0; h < 2; ++h)
#pragma unroll
                for (int i = 0; i < 2; ++i) { vA[h][i] = vN[h][i]; if (has_n2) vN[h][i] = vT[h][i] * (unsigned)KB + (unsigned)Cc[i] * 2u; }
            has_next = has_n2; nxt = n2;
        } else has_next = S.next(ui + 1, nxt);
        if constexpr (ALIGN_EPI) { if (wr == 1) PG8_BAR; }
    }
    PG8_WAIT_V(0);
    if constexpr (!ALIGN_EPI) { if (wr == 0) PG8_BAR; }
    PG8_BAR;
#undef PG8_SA
#undef PG8_SB
#undef PG8_STAGE
#undef PG8_STAGEB
#undef PG8_LDA
#undef PG8_LDB
#undef PG8_MMA
#undef PG8_RC
#undef PG8_CAT
#undef PG8_WAIT_V
#undef PG8_WAIT_L
#undef PG8_BAR
#undef PG8_SCHED
}

struct DenseSched {
    static constexpr bool GATHER = false;
    const bf16* A; const bf16* Bt; int nM, nN, G, c, KB;
    __device__ __forceinline__ bool next(int i, Unit& u) const { return order_next(nM, nN, G, c, i, u); }
    __device__ __forceinline__ const char* a_base(const Unit& u) const { return (const char*)A + (size_t)u.pm * BM * KB; }
    __device__ __forceinline__ const char* b_base(const Unit& u) const { return (const char*)Bt + (size_t)u.pn * BM * KB; }
    __device__ __forceinline__ void offsets(const Unit&, const int (&R)[2], const int (&C)[2], unsigned (&v)[2][2]) const {
#pragma unroll
        for (int h = 0; h < 2; ++h)
#pragma unroll
            for (int i = 0; i < 2; ++i) v[h][i] = (unsigned)((h * HALF + R[i]) * KB + C[i] * 2); }
    __device__ __forceinline__ void tokens(const Unit&, const int (&)[2], unsigned (&)[2][2]) const {}
};
template <bool GATHER_>
struct MoeSched {
    static constexpr bool GATHER = GATHER_;
    const void* A; const void* W; const int* rowtok; const LAS int* tstart; int TM, nN, G, c, KB; size_t wstride;
    __device__ __forceinline__ int expert(int pm) const { int e = 0;
#pragma unroll 1
        for (int i = 1; i < 32; ++i) if (pm >= tstart[i]) e = i;
        return __builtin_amdgcn_readfirstlane(e); }
    __device__ __forceinline__ bool next(int i, Unit& u) const { return order_next(TM, nN, G, c, i, u); }
    __device__ __forceinline__ const char* a_base(const Unit& u) const { return GATHER ? (const char*)A : (const char*)A + (size_t)u.pm * BM * KB; }
    __device__ __forceinline__ const char* b_base(const Unit& u) const { return (const char*)W + (size_t)expert(u.pm) * wstride + (size_t)u.pn * BM * KB; }
    __device__ __forceinline__ void tokens(const Unit& u, const int (&R)[2], unsigned (&v)[2][2]) const {
#pragma unroll
        for (int h = 0; h < 2; ++h)
#pragma unroll
            for (int i = 0; i < 2; ++i) v[h][i] = (unsigned)rowtok[(size_t)u.pm * BM + h * HALF + R[i]]; }
    __device__ __forceinline__ void offsets(const Unit& u, const int (&R)[2], const int (&C)[2], unsigned (&v)[2][2]) const {
        if (GATHER) { tokens(u, R, v);
#pragma unroll
            for (int h = 0; h < 2; ++h)
#pragma unroll
                for (int i = 0; i < 2; ++i) v[h][i] = v[h][i] * (unsigned)KB + (unsigned)C[i] * 2u; }
        else {
#pragma unroll
            for (int h = 0; h < 2; ++h)
#pragma unroll
                for (int i = 0; i < 2; ++i) v[h][i] = (unsigned)((h * HALF + R[i]) * KB + C[i] * 2); } }
};

struct EpiProj {
    static constexpr bool PERM = true;
    bf16* O; bf16* KV; bf16* QH;
    __device__ __forceinline__ void operator()(const f32x4 (&acc)[2][2][4][2], const Unit& u, int wr, int wc, int fr, int fq) const {
        const float sc = (u.pn == 8 || u.pn == 9) ? 0.125f : 1.0f;
        const int row0 = u.pm * BM + wr * 64 + fr, col0 = u.pn * BM + wc * 64 + 16 * fq;
        if (u.pn >= 8 && u.pn < 10) {
            const int ck = col0 - C_AQ;
#pragma unroll
            for (int ai = 0; ai < 2; ++ai)
#pragma unroll
                for (int m = 0; m < 4; ++m) { const int row = row0 + ai * HALF + m * 16; const int bb = row >> 12, t = row & (SEQ - 1);
#pragma unroll
                    for (int bj = 0; bj < 2; ++bj) { const int cc = ck + bj * 8; const f32x4 v0 = acc[ai][bj][m][0] * 0.125f, v1 = acc[ai][bj][m][1] * 0.125f;
                        v4u w; w.x = cvt_pk_bf16(v0[0], v0[1]); w.y = cvt_pk_bf16(v0[2], v0[3]); w.z = cvt_pk_bf16(v1[0], v1[1]); w.w = cvt_pk_bf16(v1[2], v1[3]);
                        *(v4u*)(QH + ((size_t)(bb * 8 + (cc >> 6)) * SEQ + t) * 64 + (cc & 63)) = w; } }
            return;
        }
        if (u.pn >= 10) {
            const int isv = u.pn >= 12; const int ck = col0 - (isv ? C_AV : C_AK);
#pragma unroll
            for (int ai = 0; ai < 2; ++ai)
#pragma unroll
                for (int m = 0; m < 4; ++m) { const int row = row0 + ai * HALF + m * 16; const int bb = row >> 12, t = row & (SEQ - 1);
#pragma unroll
                    for (int bj = 0; bj < 2; ++bj) { const int cc = ck + bj * 8; const f32x4 v0 = acc[ai][bj][m][0], v1 = acc[ai][bj][m][1];
                        v4u w; w.x = cvt_pk_bf16(v0[0], v0[1]); w.y = cvt_pk_bf16(v0[2], v0[3]); w.z = cvt_pk_bf16(v1[0], v1[1]); w.w = cvt_pk_bf16(v1[2], v1[3]);
                        *(v4u*)(KV + ((size_t)(bb * 8 + (cc >> 6)) * SEQ + t) * 128 + isv * 64 + (cc & 63)) = w; } }
            return;
        }
#pragma unroll
        for (int ai = 0; ai < 2; ++ai)
#pragma unroll
            for (int m = 0; m < 4; ++m) { bf16* rowp = O + (size_t)(row0 + ai * HALF + m * 16) * DPROJ + col0;
#pragma unroll
                for (int bj = 0; bj < 2; ++bj) { const f32x4 v0 = acc[ai][bj][m][0] * sc, v1 = acc[ai][bj][m][1] * sc;
                    v4u w; w.x = cvt_pk_bf16(v0[0], v0[1]); w.y = cvt_pk_bf16(v0[2], v0[3]); w.z = cvt_pk_bf16(v1[0], v1[1]); w.w = cvt_pk_bf16(v1[2], v1[3]);
                    *(v4u*)(rowp + bj * 8) = w; } }
    }
};
struct EpiRes {
    static constexpr bool PERM = true;
    const float* X; float* O;
    __device__ __forceinline__ void operator()(const f32x4 (&acc)[2][2][4][2], const Unit& u, int wr, int wc, int fr, int fq) const {
        const int col0 = u.pn * BM + wc * 64 + 16 * fq;
#pragma unroll
        for (int ai = 0; ai < 2; ++ai)
#pragma unroll
            for (int m = 0; m < 4; ++m) { const size_t off = (size_t)(u.pm * BM + ai * HALF + wr * 64 + m * 16 + fr) * DM + col0;
#pragma unroll
                for (int bj = 0; bj < 2; ++bj)
#pragma unroll
                    for (int n = 0; n < 2; ++n) { const f32x4 xv = *(const f32x4*)(X + off + bj * 8 + n * 4); *(f32x4*)(O + off + bj * 8 + n * 4) = xv + acc[ai][bj][m][n]; }
                if (m & 1) asm volatile("" ::: "memory"); }
    }
};
struct EpiSwiglu {
    static constexpr bool PERM = true;
    bf16* O; const float* bias; const LAS int* tstart;
    __device__ __forceinline__ void operator()(const f32x4 (&acc)[2][2][4][2], const Unit& u, int wr, int wc, int fr, int fq) const {
        int e = 0;
#pragma unroll 1
        for (int i = 1; i < 32; ++i) if (u.pm >= tstart[i]) e = i;
        const int row0 = u.pm * BM + wr * 64 + fr, col0 = u.pn * BM + wc * 64 + 16 * fq;
        const float* bp = bias + (size_t)e * DUP + col0;
#pragma unroll
        for (int bj = 0; bj < 2; ++bj) {
        const f32x4 bv0 = *(const f32x4*)(bp + bj * 8), bv1 = *(const f32x4*)(bp + bj * 8 + 4);
#pragma unroll
        for (int ai = 0; ai < 2; ++ai)
#pragma unroll
            for (int m = 0; m < 4; ++m) { bf16* rowp = O + (size_t)(row0 + ai * HALF + m * 16) * DEXP + (col0 >> 1);
                unsigned char* rowp8 = (unsigned char*)O + (size_t)(row0 + ai * HALF + m * 16) * DEXP + (col0 >> 1);
                { const float ws = MOE_FP8 ? FP8_WINV : 1.0f; const f32x4 v0 = acc[ai][bj][m][0] * ws + bv0, v1 = acc[ai][bj][m][1] * ws + bv1;
                    float r[4];
#pragma unroll
                    for (int p = 0; p < 4; ++p) { const float gl = fminf(p < 2 ? v0[2 * p] : v1[2 * p - 4], 7.0f); const float li = fminf(fmaxf(p < 2 ? v0[2 * p + 1] : v1[2 * p - 3], -7.0f), 7.0f);
                        r[p] = gl * __builtin_amdgcn_rcpf(1.0f + __builtin_amdgcn_exp2f(-1.702f * 1.4426950408889634f * gl)) * (li + 1.0f); }
                    if (MOE_FP8) *(unsigned*)(rowp8 + bj * 4) = pk4_fp8(r[0], r[1], r[2], r[3]);
                    else { v2u w; w.x = cvt_pk_bf16(r[0], r[1]); w.y = cvt_pk_bf16(r[2], r[3]); *(v2u*)(rowp + bj * 4) = w; } } }
        }
    }
};
struct EpiY {
    static constexpr bool PERM = true;
    bf16* O; const float* bias; const LAS int* tstart;
    __device__ __forceinline__ void operator()(const f32x4 (&acc)[2][2][4][2], const Unit& u, int wr, int wc, int fr, int fq) const {
        int e = 0;
#pragma unroll 1
        for (int i = 1; i < 32; ++i) if (u.pm >= tstart[i]) e = i;
        const int row0 = u.pm * BM + wr * 64 + fr, col0 = u.pn * BM + wc * 64 + 16 * fq;
        const float* bp = bias + (size_t)e * DM + col0;
        f32x4 bv[2][2];
#pragma unroll
        for (int bj = 0; bj < 2; ++bj)
#pragma unroll
            for (int n = 0; n < 2; ++n) bv[bj][n] = *(const f32x4*)(bp + bj * 8 + 4 * n);
#pragma unroll
        for (int ai = 0; ai < 2; ++ai)
#pragma unroll
            for (int m = 0; m < 4; ++m) { bf16* rowp = O + (size_t)(row0 + ai * HALF + m * 16) * DM + col0;
#pragma unroll
                for (int bj = 0; bj < 2; ++bj) { const float ws = MOE_FP8 ? FP8_WINV : 1.0f; const f32x4 v0 = acc[ai][bj][m][0] * ws + bv[bj][0], v1 = acc[ai][bj][m][1] * ws + bv[bj][1];
                    v4u w; w.x = cvt_pk_bf16(v0[0], v0[1]); w.y = cvt_pk_bf16(v0[2], v0[3]); w.z = cvt_pk_bf16(v1[0], v1[1]); w.w = cvt_pk_bf16(v1[2], v1[3]);
                    *(v4u*)(rowp + bj * 8) = w; } }
    }
};
}

#ifndef FAST_GEMM
#define FAST_GEMM 1
#endif
__device__ __forceinline__ void phase1(const Args& a, const Frame& F) {
    const bf16* xn = (const bf16*)(a.ws + WS_XN); const bf16* win = (const bf16*)(a.ws + WS_WIN); bf16* proj = (bf16*)(a.ws + WS_PROJ);
#if FAST_GEMM
    { pg8::DenseSched S{xn, win, NT / 256, DPROJ / 256, F.G, F.bid, DM * 2}; pg8::EpiProj E{proj, (bf16*)(a.ws + WS_KV), (bf16*)(a.ws + WS_QH)}; pg8::gemm_phase<pg8::EpiProj, pg8::DenseSched, true>(F.lds, DM * 2, S, E, a.ws); return; }
#endif
    constexpr int NPN = DPROJ / 128, NU = (NT / 256) * NPN;
    for (int u = F.bid; u < NU; u += F.G) {
        const int pm = u / NPN, pn = u % NPN;
        const bf16* A0 = xn + (size_t)pm * 256 * DM;
        auto rp = [&](int r) { return A0 + (size_t)r * DM; };
        bf16* O = proj + (size_t)pm * 256 * DPROJ + pn * 128;
        const float sc = (pn * 128 >= C_AQ && pn * 128 < C_AK) ? 0.125f : 1.0f;
        auto epi = [&](int r, int c, const f32x4& v) { v2u w; w.x = pk2(v.x * sc, v.y * sc); w.y = pk2(v.z * sc, v.w * sc); *(v2u*)(O + (size_t)r * DPROJ + c) = w; };
        gemm_unit_simple(rp, win + (size_t)pn * 128 * DM, DM, epi, F.wave, F.lane);
    }
}

__device__ __forceinline__ void hgrn_simple(const Args& a, const Frame& F, int item) {
    const int b = item >> 2, h = item & 3;
    const bf16* proj = (const bf16*)(a.ws + WS_PROJ); bf16* mix = (bf16*)(a.ws + WS_MIX);
    LAS float* stage = (LAS float*)F.lds;
    LAS float* spart = (LAS float*)(F.lds + 32768);
    LAS float* wsum = (LAS float*)(F.lds + 32768 + 2048);
    const int tid = F.tid, v = tid & 127, kq = tid >> 7;
    float S[32];
#pragma unroll
    for (int i = 0; i < 32; ++i) S[i] = 0.f;
    const int scol = (kq == 0 ? C_HQ : kq == 1 ? C_HF : kq == 2 ? C_HI : C_HG) + h * 128 + v;
    float lbv = 0.f;
    { const float l0 = a.lb_logits[h * 128 + v], l1 = a.lb_logits[DH + h * 128 + v]; lbv = 1.0f / (1.0f + __expf(l1 - l0)); }
    const float gn = a.hgrn_g[h * 128 + v];
    const bf16* pbase = proj + (size_t)b * SEQ * DPROJ + scol;
    float pre[8];
#pragma unroll
    for (int i = 0; i < 8; ++i) pre[i] = bf2f(pbase[(size_t)i * DPROJ]);
    for (int t0 = 0; t0 < SEQ; t0 += 8) {
        const int buf = (t0 >> 3) & 1;
        LAS float* st = stage + buf * 4096;
#pragma unroll
        for (int i = 0; i < 8; ++i) { float val = pre[i]; if (kq == 1) val = lbv + (1.0f - lbv) / (1.0f + __expf(-val)); st[i * 512 + tid] = val; }
        if (t0 + 8 < SEQ) {
#pragma unroll
            for (int i = 0; i < 8; ++i) pre[i] = bf2f(pbase[(size_t)(t0 + 8 + i) * DPROJ]);
        }
        __syncthreads();
#pragma unroll 1
        for (int i = 0; i < 8; ++i) {
            const LAS float* sq = st + i * 512; const LAS float* sf = sq + 128; const LAS float* sv = sq + 256; const LAS float* sg = sq + 384;
            const float vv = sv[v]; float part = 0.f;
#pragma unroll
            for (int j = 0; j < 32; ++j) { const int k = kq * 32 + j; const float f = sf[k]; S[j] = f * S[j] + (1.0f - f) * vv; part += sq[k] * S[j]; }
            spart[kq * 128 + v] = part;
            __syncthreads();
            float o = 0.f;
            if (tid < 128) { o = (spart[v] + spart[128 + v]) + (spart[256 + v] + spart[384 + v]); const float ss = wave_sum(o * o); if (F.lane == 0) wsum[F.wave] = ss; }
            __syncthreads();
            if (tid < 128) {
                const float ms = (wsum[0] + wsum[1]) * (1.0f / 128.0f); const float r = 1.0f / sqrtf(ms + EPS);
                const float g = sg[v]; const float silu = g / (1.0f + __expf(-g));
                mix[(size_t)(b * SEQ + t0 + i) * DM + h * 128 + v] = (bf16)f2bf(o * r * gn * silu);
            }
        }
    }
    __syncthreads();
}

__device__ __forceinline__ void attn_simple(const Args& a, const Frame& F, int first_wave, int n_waves) {
    const bf16* proj = (const bf16*)(a.ws + WS_PROJ); bf16* mix = (bf16*)(a.ws + WS_MIX);
    const int lane = F.lane;
    for (int item = first_wave; item < NT * 8; item += n_waves) {
        const int row = item >> 3, h = item & 7, t = row & (SEQ - 1), b = row >> 12;
        const float qd = bf2f(proj[(size_t)row * DPROJ + C_AQ + h * 64 + lane]);
        const bf16* kb = proj + (size_t)b * SEQ * DPROJ + C_AK + h * 64;
        const bf16* vb = proj + (size_t)b * SEQ * DPROJ + C_AV + h * 64;
        float m = -INFINITY, l = 0.f, o = 0.f;
#pragma unroll 1
        for (int p = 0; p < 3; ++p) {
            const int dil = (p == 0) ? 1 : (p == 1 ? 4 : 16);
            const int mq = t / dil; const int nkeys = (mq < 128 ? mq : 128) + 1;
#pragma unroll 1
            for (int j0 = 0; j0 < nkeys; j0 += 64) {
                const int j = j0 + lane; const bool valid = j < nkeys; const int kt = valid ? (t - j * dil) : t;
                const v4u* kr = (const v4u*)(kb + (size_t)kt * DPROJ);
                float s = 0.f;
#pragma unroll
                for (int c = 0; c < 8; ++c) { const v4u w = kr[c];
                    s += bflo(w.x) * RL(qd, 8 * c + 0) + bfhi(w.x) * RL(qd, 8 * c + 1) + bflo(w.y) * RL(qd, 8 * c + 2) + bfhi(w.y) * RL(qd, 8 * c + 3)
                       + bflo(w.z) * RL(qd, 8 * c + 4) + bfhi(w.z) * RL(qd, 8 * c + 5) + bflo(w.w) * RL(qd, 8 * c + 6) + bfhi(w.w) * RL(qd, 8 * c + 7); }
                s = valid ? s : -INFINITY;
                const float mn = fmaxf(m, wave_max(s));
                const float pj = valid ? __expf(s - mn) : 0.f; const float alpha = __expf(m - mn);
                l = l * alpha + wave_sum(pj); o *= alpha; m = mn;
                const int nv = (nkeys - j0) < 64 ? (nkeys - j0) : 64;
#pragma unroll 1
                for (int jj = 0; jj < nv; ++jj) { const float pv = RL(pj, jj); o += pv * bf2f(vb[(size_t)(t - (j0 + jj) * dil) * DPROJ + lane]); }
            }
        }
        o = o / l;
        const float ms = wave_sum(o * o) * (1.0f / 64.0f); const float r = 1.0f / sqrtf(ms + EPS);
        mix[(size_t)row * DM + DH + h * 64 + lane] = (bf16)f2bf(o * r * a.attn_g[h * 64 + lane]);
    }
}

typedef float f32x16 __attribute__((ext_vector_type(16)));
typedef float f32x8 __attribute__((ext_vector_type(8)));
typedef short s16x4 __attribute__((ext_vector_type(4)));
typedef __bf16 bf16x8_t __attribute__((ext_vector_type(8)));
typedef __bf16 bf16x4_t __attribute__((ext_vector_type(4)));
#define MFMA32(a, b, c) __builtin_amdgcn_mfma_f32_32x32x16_bf16((a), (b), (c), 0, 0, 0)
__device__ __forceinline__ int crow(int reg, int h) { return (reg & 3) + 8 * (reg >> 2) + 4 * h; }
#define PACK8(x, s) __builtin_bit_cast(bf16x8, __builtin_convertvector((f32x8){(x)[8 * (s)], (x)[8 * (s) + 1], (x)[8 * (s) + 2], (x)[8 * (s) + 3], (x)[8 * (s) + 4], (x)[8 * (s) + 5], (x)[8 * (s) + 6], (x)[8 * (s) + 7]}, bf16x8_t))
#define TR16(p) __builtin_amdgcn_ds_read_tr16_b64_v4i16((LAS s16x4*)(p))
constexpr int ATT_TASKS = NBATCH * 8 * 3 * 128;
constexpr int ATT_WLDS = 6144, ATT_VSTR = 192, ATT_OSTR = 144;
constexpr float LOG2E = 1.4426950408889634f, LN2 = 0.6931471805599453f;

__device__ __forceinline__ void attn_task(const bf16* proj, bf16* op, float* lse, LAS unsigned char* wl, int task, int lane) {
    const int qt = task & 127; int rr = task >> 7; const int p = rr % 3; rr /= 3; const int h = rr & 7, b = rr >> 3;
    const int dsh = 2 * p, tpc = 128 >> dsh, r = qt / tpc, m0 = (qt & (tpc - 1)) << 5;
    const int c = lane & 31, h2 = lane >> 5;
    const bf16* base = proj + (size_t)b * SEQ * DPROJ + h * 64;
    const int tq = ((m0 + c) << dsh) + r;
    bf16x8 qf[4];
    { const bf16* qp = base + (size_t)tq * DPROJ + C_AQ + 8 * h2;
#pragma unroll
      for (int s = 0; s < 4; ++s) qf[s] = *(const bf16x8*)(qp + 16 * s); }
    const int kt0 = m0 >= 128 ? 0 : ((128 - m0) >> 5);
    f32x16 st[5];
#pragma unroll
    for (int kt = 0; kt < 5; ++kt) {
#pragma unroll
        for (int i = 0; i < 16; ++i) st[kt][i] = 0.f;
        if (kt >= kt0) {
            const int tk = ((m0 - 128 + 32 * kt + c) << dsh) + r;
            const bf16* kp = base + (size_t)tk * DPROJ + C_AK + 8 * h2;
            bf16x8 kf[4];
#pragma unroll
            for (int s = 0; s < 4; ++s) kf[s] = *(const bf16x8*)(kp + 16 * s);
#pragma unroll
            for (int s = 0; s < 4; ++s) st[kt] = MFMA32(kf[s], qf[s], st[kt]);
        }
    }
    float mx = -INFINITY;
#pragma unroll
    for (int kt = 0; kt < 5; ++kt)
#pragma unroll
        for (int i = 0; i < 16; ++i) { const int kl = crow(i, h2); const bool valid = (kt >= kt0) && (kt == 0 ? kl >= c : (kt == 4 ? kl <= c : true));
            const float s = valid ? st[kt][i] : -INFINITY; st[kt][i] = s; mx = fmaxf(mx, s); }
    mx = fmaxf(mx, __shfl_xor(mx, 32));
    float l = 0.f; const float mb = mx * LOG2E;
#pragma unroll
    for (int kt = 0; kt < 5; ++kt)
#pragma unroll
        for (int i = 0; i < 16; ++i) { const float pv = __builtin_amdgcn_exp2f(st[kt][i] * LOG2E - mb); st[kt][i] = pv; l += pv; }
    l += __shfl_xor(l, 32);
    f32x16 o0, o1;
#pragma unroll
    for (int i = 0; i < 16; ++i) { o0[i] = 0.f; o1[i] = 0.f; }
    const int g4 = lane >> 4, i16 = lane & 15, q4 = i16 >> 2, p4 = i16 & 3, blk = g4 & 1;
    LAS unsigned char* trb = wl + (4 * h2 + q4) * ATT_VSTR + (16 * blk + 4 * p4) * 2;
#pragma unroll
    for (int kt = 0; kt < 5; ++kt) {
        if (kt >= kt0) {
            v4u vr[4];
#pragma unroll
            for (int i = 0; i < 4; ++i) { const int row = (lane >> 3) + 8 * i; const int tk = ((m0 - 128 + 32 * kt + row) << dsh) + r;
                vr[i] = *(const v4u*)(base + (size_t)tk * DPROJ + C_AV + 8 * (lane & 7)); }
#pragma unroll
            for (int i = 0; i < 4; ++i) *(LAS v4u*)(wl + ((lane >> 3) + 8 * i) * ATT_VSTR + (lane & 7) * 16) = vr[i];
#pragma unroll
            for (int s = 0; s < 2; ++s) {
                const bf16x8 pf = PACK8(st[kt], s);
                const s16x4 a0 = TR16(trb + (16 * s) * ATT_VSTR), a1 = TR16(trb + (16 * s + 8) * ATT_VSTR);
                const s16x4 c0 = TR16(trb + (16 * s) * ATT_VSTR + 64), c1 = TR16(trb + (16 * s + 8) * ATT_VSTR + 64);
                o0 = MFMA32(__builtin_shufflevector(a0, a1, 0, 1, 2, 3, 4, 5, 6, 7), pf, o0);
                o1 = MFMA32(__builtin_shufflevector(c0, c1, 0, 1, 2, 3, 4, 5, 6, 7), pf, o1);
            }
        }
    }
    const float inv = 1.0f / l;
#pragma unroll
    for (int g = 0; g < 4; ++g) {
        const bf16x4_t w0 = __builtin_convertvector((f32x4){o0[4 * g] * inv, o0[4 * g + 1] * inv, o0[4 * g + 2] * inv, o0[4 * g + 3] * inv}, bf16x4_t);
        const bf16x4_t w1 = __builtin_convertvector((f32x4){o1[4 * g] * inv, o1[4 * g + 1] * inv, o1[4 * g + 2] * inv, o1[4 * g + 3] * inv}, bf16x4_t);
        *(LAS v2u*)(wl + c * ATT_OSTR + (8 * g + 4 * h2) * 2) = __builtin_bit_cast(v2u, w0);
        *(LAS v2u*)(wl + c * ATT_OSTR + (32 + 8 * g + 4 * h2) * 2) = __builtin_bit_cast(v2u, w1);
    }
    bf16* ob = op + (size_t)p * NT * DH + (size_t)b * SEQ * DH + h * 64;
#pragma unroll
    for (int i = 0; i < 4; ++i) { const int row = (lane >> 3) + 8 * i; const v4u w = *(const LAS v4u*)(wl + row * ATT_OSTR + (lane & 7) * 16);
        const int tok = ((m0 + row) << dsh) + r; *(v4u*)(ob + (size_t)tok * DH + 8 * (lane & 7)) = w; }
    if (h2 == 0) lse[(size_t)p * NT * 8 + (size_t)(b * SEQ + tq) * 8 + h] = mx + __builtin_amdgcn_logf(l) * LN2;
}

constexpr int ATT_ITEMS = NBATCH * 8 * 3 * 16;
constexpr int AT_KI = 0, AT_VI = 49152, AT_WO = 98304, AT_WOB = 4608;
struct AttItem { int b, h, dsh, r, m0; };
__device__ __forceinline__ AttItem att_decode(int item) { AttItem t; const int j = item & 15; int rr = item >> 4; const int p = rr % 3; rr /= 3; t.h = rr & 7; t.b = rr >> 3; t.dsh = 2 * p; const int gpc = 16 >> t.dsh; t.r = j / gpc; t.m0 = (j % gpc) << 8; return t; }
__device__ __forceinline__ void att_load(const bf16* kvb, const AttItem& t, int tid, v4u (&kr)[12]) {
    const bf16* base = kvb + (size_t)(t.b * 8 + t.h) * SEQ * 128 + 8 * (tid & 15);
#pragma unroll
    for (int n = 0; n < 12; ++n) { const int row = (tid >> 4) + 32 * n; const int mk = t.m0 - 128 + row;
        if (mk >= 0) kr[n] = *(const v4u*)(base + (size_t)((mk << t.dsh) + t.r) * 128); }
}
__device__ __forceinline__ void att_stage(LAS unsigned char* L, int tid, const v4u (&kr)[12]) {
    const int pc = tid & 15, ch = pc & 7, isv = pc >> 3;
#pragma unroll
    for (int n = 0; n < 12; ++n) { const int row = (tid >> 4) + 32 * n;
        const int off = isv ? (AT_VI + row * 128 + 16 * (ch ^ (((row >> 1) & 1) << 2))) : (AT_KI + row * 128 + 16 * (ch ^ ((row >> 1) & 7)));
        *(LAS v4u*)(L + off) = kr[n]; }
}
__device__ __forceinline__ void att_scores(LAS unsigned char* L, const AttItem& t, const bf16x8 (&qf)[4], bf16x8 (&pfr)[5][2], float& mx_out, float& l_out, int w, int lane) {
    const int c = lane & 31, h2 = lane >> 5, m0 = t.m0 + 32 * w;
    const int kt0 = m0 >= 128 ? 0 : ((128 - m0) >> 5);
    f32x16 st[5];
#pragma unroll
    for (int kt = 0; kt < 5; ++kt) {
#pragma unroll
        for (int i = 0; i < 16; ++i) st[kt][i] = 0.f;
        if (kt >= kt0) { const int row = 32 * (w + kt) + c;
#pragma unroll
            for (int s = 0; s < 4; ++s) { const bf16x8 kf = *(const LAS bf16x8*)(L + AT_KI + row * 128 + 16 * ((2 * s + h2) ^ ((row >> 1) & 7))); st[kt] = MFMA32(kf, qf[s], st[kt]); } }
    }
    float mx = -INFINITY;
#pragma unroll
    for (int kt = 0; kt < 5; ++kt)
#pragma unroll
        for (int i = 0; i < 16; ++i) { const int kl = crow(i, h2); const bool valid = (kt >= kt0) && (kt == 0 ? kl >= c : (kt == 4 ? kl <= c : true));
            const float s = valid ? st[kt][i] : -INFINITY; st[kt][i] = s; mx = fmaxf(mx, s); }
    mx = fmaxf(mx, __shfl_xor(mx, 32));
    float l = 0.f; const float mb = mx * LOG2E;
#pragma unroll
    for (int kt = 0; kt < 5; ++kt)
#pragma unroll
        for (int i = 0; i < 16; ++i) { const float pv = __builtin_amdgcn_exp2f(st[kt][i] * LOG2E - mb); st[kt][i] = pv; l += pv; }
    l += __shfl_xor(l, 32);
#pragma unroll
    for (int kt = 0; kt < 5; ++kt) { pfr[kt][0] = PACK8(st[kt], 0); pfr[kt][1] = PACK8(st[kt], 1); }
    mx_out = mx; l_out = l;
}
__device__ __forceinline__ void att_pv(bf16* op, float* lse, LAS unsigned char* L, const AttItem& t, const bf16x8 (&pfr)[5][2], float mx, float l, int w, int lane) {
    const int c = lane & 31, h2 = lane >> 5, dsh = t.dsh, r = t.r, m0 = t.m0 + 32 * w, p = dsh >> 1;
    const int tq = ((m0 + c) << dsh) + r;
    const int kt0 = m0 >= 128 ? 0 : ((128 - m0) >> 5);
    f32x16 o0, o1;
#pragma unroll
    for (int i = 0; i < 16; ++i) { o0[i] = 0.f; o1[i] = 0.f; }
    const int g4 = lane >> 4, i16 = lane & 15, q4 = i16 >> 2, p4 = i16 & 3, blk = g4 & 1;
#pragma unroll
    for (int kt = 0; kt < 5; ++kt) {
        if (kt >= kt0) {
#pragma unroll
            for (int s = 0; s < 2; ++s) {
                const bf16x8 pf = pfr[kt][s];
                const int ra = 32 * (w + kt) + 16 * s + 4 * h2 + q4, rb = ra + 8;
                const int sa = ((ra >> 1) & 1) << 2, sb = ((rb >> 1) & 1) << 2, ch0 = 2 * blk + (p4 >> 1), hf = 8 * (p4 & 1);
                const s16x4 a0 = TR16(L + AT_VI + ra * 128 + 16 * (ch0 ^ sa) + hf), a1 = TR16(L + AT_VI + rb * 128 + 16 * (ch0 ^ sb) + hf);
                const s16x4 c0 = TR16(L + AT_VI + ra * 128 + 16 * ((4 + ch0) ^ sa) + hf), c1 = TR16(L + AT_VI + rb * 128 + 16 * ((4 + ch0) ^ sb) + hf);
                o0 = MFMA32(__builtin_shufflevector(a0, a1, 0, 1, 2, 3, 4, 5, 6, 7), pf, o0);
                o1 = MFMA32(__builtin_shufflevector(c0, c1, 0, 1, 2, 3, 4, 5, 6, 7), pf, o1);
            }
        }
    }
    const float inv = 1.0f / l;
    LAS unsigned char* wl = L + AT_WO + w * AT_WOB;
#pragma unroll
    for (int g = 0; g < 4; ++g) {
        const bf16x4_t w0 = __builtin_convertvector((f32x4){o0[4 * g] * inv, o0[4 * g + 1] * inv, o0[4 * g + 2] * inv, o0[4 * g + 3] * inv}, bf16x4_t);
        const bf16x4_t w1 = __builtin_convertvector((f32x4){o1[4 * g] * inv, o1[4 * g + 1] * inv, o1[4 * g + 2] * inv, o1[4 * g + 3] * inv}, bf16x4_t);
        *(LAS v2u*)(wl + c * ATT_OSTR + (8 * g + 4 * h2) * 2) = __builtin_bit_cast(v2u, w0);
        *(LAS v2u*)(wl + c * ATT_OSTR + (32 + 8 * g + 4 * h2) * 2) = __builtin_bit_cast(v2u, w1);
    }
    bf16* ob = op + (size_t)p * NT * DH + (size_t)t.b * SEQ * DH + t.h * 64;
#pragma unroll
    for (int i = 0; i < 4; ++i) { const int row = (lane >> 3) + 8 * i; const v4u wv = *(const LAS v4u*)(wl + row * ATT_OSTR + (lane & 7) * 16);
        const int tok = ((m0 + row) << dsh) + r; *(v4u*)(ob + (size_t)tok * DH + 8 * (lane & 7)) = wv; }
    if (h2 == 0) lse[(size_t)p * NT * 8 + (size_t)(t.b * SEQ + tq) * 8 + t.h] = mx + __builtin_amdgcn_logf(l) * LN2;
}
__device__ __forceinline__ void attn_items(const Args& a, const Frame& F) {
    const bf16* proj = (const bf16*)(a.ws + WS_PROJ); bf16* op = (bf16*)(a.ws + WS_OP); float* lse = (float*)(a.ws + WS_LSE);
    LAS unsigned char* L = F.lds; const int lane = F.lane, w = F.wave, c = lane & 31, h2 = lane >> 5;
    const bf16* kvb = (const bf16*)(a.ws + WS_KV); const bf16* qhb = (const bf16*)(a.ws + WS_QH);
    v4u kr[12];
#pragma unroll
    for (int n = 0; n < 12; ++n) kr[n] = (v4u){0u, 0u, 0u, 0u};
    const bool xl = (F.G % 8 == 0) && (ATT_ITEMS % (F.G / 8) == 0 || true);
    const int nlb = xl ? F.G / 8 : F.G, lb = xl ? (F.bid >> 3) : F.bid, xc = xl ? (F.bid & 7) : 0;
#define ATT_ITEM_OF(n_) (xl ? ((((lb + nlb * (n_)) / 48) * 8 + xc) * 48 + (lb + nlb * (n_)) % 48) : (lb + nlb * (n_)))
    const int nit = xl ? (ATT_ITEMS / 8 - lb + nlb - 1) / nlb : (ATT_ITEMS - lb + nlb - 1) / nlb;
    int item = nit > 0 ? ATT_ITEM_OF(0) : ATT_ITEMS;
    if (nit > 0) { const AttItem t0 = att_decode(item); att_load(kvb, t0, F.tid, kr); }
    bf16x8 qf[4], qn[4];
#define ATT_QLOAD(dst, t_) do { const int tq_ = (((t_).m0 + 32 * w + c) << (t_).dsh) + (t_).r; const bf16* qp_ = qhb + ((size_t)((t_).b * 8 + (t_).h) * SEQ + tq_) * 64 + 8 * h2; \
        _Pragma("unroll") for (int s_ = 0; s_ < 4; ++s_) dst[s_] = *(const bf16x8*)(qp_ + 16 * s_); } while (0)
#pragma unroll
    for (int s = 0; s < 4; ++s) { qf[s] = (bf16x8){0, 0, 0, 0, 0, 0, 0, 0}; qn[s] = qf[s]; }
    if (nit > 0) { const AttItem t0 = att_decode(item); ATT_QLOAD(qf, t0); }
#pragma unroll 1
    for (int n = 0; n < nit; ++n) {
        const AttItem t = att_decode(item);
        att_stage(L, F.tid, kr);
        __syncthreads();
        if (n + 1 < nit) { item = ATT_ITEM_OF(n + 1); const AttItem tn = att_decode(item); att_load(kvb, tn, F.tid, kr); ATT_QLOAD(qn, tn); }
        bf16x8 pfr[5][2]; float mx, l;
        if (!((PROBE_SKIP & 16) && a.li == 1)) {
        att_scores(L, t, qf, pfr, mx, l, w, lane);
        if (!((PROBE_SKIP & 8) && a.li == 1)) att_pv(op, lse, L, t, pfr, mx, l, w, lane);
        }
#pragma unroll
        for (int s = 0; s < 4; ++s) qf[s] = qn[s];
        __syncthreads();
    }
#undef ATT_QLOAD
#undef ATT_ITEM_OF
}

__device__ __forceinline__ void attn_combine(const Args& a, const Frame& F) {
    const bf16* op = (const bf16*)(a.ws + WS_OP); const float* lse = (const float*)(a.ws + WS_LSE); bf16* mix = (bf16*)(a.ws + WS_MIX);
    const int gw = F.bid * NWAVES + F.wave, NGW = F.G * NWAVES, lane = F.lane, hh = lane >> 3, d0 = 8 * (lane & 7);
    f32x4 g0 = *(const f32x4*)(a.attn_g + hh * 64 + d0), g1 = *(const f32x4*)(a.attn_g + hh * 64 + d0 + 4);
    for (int t = gw; t < NT; t += NGW) {
        const float l0 = lse[(size_t)t * 8 + hh], l1 = lse[(size_t)NT * 8 + (size_t)t * 8 + hh], l2 = lse[(size_t)2 * NT * 8 + (size_t)t * 8 + hh];
        const float mx = fmaxf(l0, fmaxf(l1, l2)); const float e0 = __expf(l0 - mx), e1 = __expf(l1 - mx), e2 = __expf(l2 - mx); const float inv = 1.0f / (e0 + e1 + e2);
        const v4u w0 = *(const v4u*)(op + (size_t)t * DH + hh * 64 + d0), w1 = *(const v4u*)(op + (size_t)NT * DH + (size_t)t * DH + hh * 64 + d0), w2 = *(const v4u*)(op + (size_t)2 * NT * DH + (size_t)t * DH + hh * 64 + d0);
        float o[8]; const float a0 = e0 * inv, a1 = e1 * inv, a2 = e2 * inv;
        o[0] = a0 * bflo(w0.x) + a1 * bflo(w1.x) + a2 * bflo(w2.x); o[1] = a0 * bfhi(w0.x) + a1 * bfhi(w1.x) + a2 * bfhi(w2.x);
        o[2] = a0 * bflo(w0.y) + a1 * bflo(w1.y) + a2 * bflo(w2.y); o[3] = a0 * bfhi(w0.y) + a1 * bfhi(w1.y) + a2 * bfhi(w2.y);
        o[4] = a0 * bflo(w0.z) + a1 * bflo(w1.z) + a2 * bflo(w2.z); o[5] = a0 * bfhi(w0.z) + a1 * bfhi(w1.z) + a2 * bfhi(w2.z);
        o[6] = a0 * bflo(w0.w) + a1 * bflo(w1.w) + a2 * bflo(w2.w); o[7] = a0 * bfhi(w0.w) + a1 * bfhi(w1.w) + a2 * bfhi(w2.w);
        float ss = 0.f;
#pragma unroll
        for (int j = 0; j < 8; ++j) ss += o[j] * o[j];
        ss += __shfl_xor(ss, 1); ss += __shfl_xor(ss, 2); ss += __shfl_xor(ss, 4);
        const float rn = 1.0f / sqrtf(ss * (1.0f / 64.0f) + EPS);
        v4u w; w.x = pk2(o[0] * rn * g0.x, o[1] * rn * g0.y); w.y = pk2(o[2] * rn * g0.z, o[3] * rn * g0.w); w.z = pk2(o[4] * rn * g1.x, o[5] * rn * g1.y); w.w = pk2(o[6] * rn * g1.z, o[7] * rn * g1.w);
        *(v4u*)(mix + (size_t)t * DM + DH + hh * 64 + d0) = w;
    }
}

#ifndef FAST_ATTN
#define FAST_ATTN 1
#endif
constexpr int HG_LB = 0, HG_QT = 32768, HG_KT = 49152, HG_VV = 65536, HG_SM = 81920, HG_TOT = 114688, HG_PRE = 116736, HG_BMID = 118784, HG_EMID = 119296, HG_DLAST = 119808, HG_CFAC = 120320, HG_LBV = 120832, HG_GNV = 121344;
#define HSWZ(row, ch) (256 * (row) + 16 * ((ch) ^ ((((row) & 3) << 2) | (((row) >> 2) & 3))))
__device__ __forceinline__ float bfel(const v4u& w, int j) { const unsigned x = (j >> 1) == 0 ? w.x : (j >> 1) == 1 ? w.y : (j >> 1) == 2 ? w.z : w.w; return (j & 1) ? bfhi(x) : bflo(x); }

constexpr int HG_BSV = 121856, HG_BSC = 122368;
constexpr int HG_NSEG = 8, HG_SEGCH = SEQ / 64 / HG_NSEG;
__device__ __forceinline__ void hgrn_chunked(const Args& a, const Frame& F, int item) {
    const int seg = item & 7, h = (item >> 3) & 3, b = item >> 5;
    const bf16* proj = (const bf16*)(a.ws + WS_PROJ); bf16* oa = (bf16*)(a.ws + WS_OA); bf16* qpp = (bf16*)(a.ws + WS_QPP);
    LAS unsigned char* L = F.lds;
    const int tid = F.tid, lane = F.lane, w = F.wave, tt = w >> 2, vt = w & 3, c = lane & 31, h2 = lane >> 5;
    const int et = tid >> 3, ec = tid & 7;
    const int g4 = lane >> 4, i16 = lane & 15, q4 = i16 >> 2, p4 = i16 & 3, blk = g4 & 1, pe = ((p4 & 1) << 1) | (p4 >> 1);
    LAS float* LB = (LAS float*)(L + HG_LB); LAS float* TOT = (LAS float*)(L + HG_TOT); LAS float* PRE = (LAS float*)(L + HG_PRE);
    LAS float* BMID = (LAS float*)(L + HG_BMID); LAS float* EMID = (LAS float*)(L + HG_EMID); LAS float* DLAST = (LAS float*)(L + HG_DLAST); LAS float* CFAC = (LAS float*)(L + HG_CFAC);
    LAS float* LBV = (LAS float*)(L + HG_LBV); LAS float* BSV = (LAS float*)(L + HG_BSV); LAS float* BSC = (LAS float*)(L + HG_BSC);
    if (tid < 128) { const float l0 = a.lb_logits[h * 128 + tid], l1 = a.lb_logits[DH + h * 128 + tid]; LBV[tid] = 1.0f / (1.0f + __expf(l1 - l0)); BSV[tid] = 0.f; }
    f32x16 S0, S1;
#pragma unroll
    for (int i = 0; i < 16; ++i) { S0[i] = 0.f; S1[i] = 0.f; }
    const int tok0 = b * SEQ + seg * (SEQ / HG_NSEG);
    const bf16* prow = proj + (size_t)(tok0 + et) * DPROJ + h * 128;
    v4u pq[2], pf[2], pv[2];
#pragma unroll
    for (int i = 0; i < 2; ++i) { pq[i] = *(const v4u*)(prow + C_HQ + 8 * (ec + 8 * i)); pf[i] = *(const v4u*)(prow + C_HF + 8 * (ec + 8 * i)); pv[i] = *(const v4u*)(prow + C_HI + 8 * (ec + 8 * i)); }
    __syncthreads();
#pragma unroll 1
    for (int ch = 0; ch < HG_SEGCH; ++ch) {
        int lane_ = lane, tid_ = tid; asm volatile("" : "+v"(lane_), "+v"(tid_));
        const int c = lane_ & 31, h2 = lane_ >> 5, et = tid_ >> 3, ec = tid_ & 7;
        const int g4 = lane_ >> 4, i16 = lane_ & 15, q4 = i16 >> 2, p4 = i16 & 3, blk = g4 & 1, pe = ((p4 & 1) << 1) | (p4 >> 1);
        const bf16* crow_ = prow + (size_t)ch * 64 * DPROJ;
        float kf_[16];
#pragma unroll
        for (int i = 0; i < 2; ++i) { const int ci = ec + 8 * i; float lf[8];
#pragma unroll
            for (int j = 0; j < 8; ++j) { const float fl = bfel(pf[i], j), lb = LBV[8 * ci + j]; const float f = lb + (1.0f - lb) * __builtin_amdgcn_rcpf(1.0f + __builtin_amdgcn_exp2f(-fl * LOG2E)); kf_[8 * i + j] = 1.0f - f; lf[j] = __builtin_amdgcn_logf(f) * LN2; }
            *(LAS f32x4*)(LB + et * 128 + 8 * ci) = (f32x4){lf[0], lf[1], lf[2], lf[3]}; *(LAS f32x4*)(LB + et * 128 + 8 * ci + 4) = (f32x4){lf[4], lf[5], lf[6], lf[7]};
            *(LAS v4u*)(L + HG_VV + HSWZ(et, ci)) = pv[i]; }
        __syncthreads();
        { const int k = tid & 127, part = tid >> 7; float run = 0.f;
#pragma unroll
          for (int r = 0; r < 16; ++r) { const int row = 16 * part + r; run += LB[row * 128 + k]; LB[row * 128 + k] = run; }
          TOT[part * 128 + k] = run; }
        __syncthreads();
        if (tid < 128) { const float t0 = TOT[tid], t1 = TOT[128 + tid], t2 = TOT[256 + tid]; PRE[tid] = 0.f; PRE[128 + tid] = t0; PRE[256 + tid] = t0 + t1; PRE[384 + tid] = t0 + t1 + t2;
            const float bmr = LB[31 * 128 + tid] + t0, bl = LB[63 * 128 + tid] + t0 + t1 + t2; const float bm = fmaxf(bmr, -80.0f);
            BMID[tid] = bm; EMID[tid] = __builtin_amdgcn_exp2f(bm * LOG2E); DLAST[tid] = __builtin_amdgcn_exp2f(bl * LOG2E); CFAC[tid] = __builtin_amdgcn_exp2f((bl - bm) * LOG2E);
            const float bs = BSV[tid]; BSC[tid] = bs; BSV[tid] = bs + bl; }
        __syncthreads();
#pragma unroll
        for (int i = 0; i < 2; ++i) { const int ci = ec + 8 * i; f32x8 qv, kv, qs;
#pragma unroll
            for (int j = 0; j < 8; ++j) { const float bb = LB[et * 128 + 8 * ci + j] + PRE[(et >> 4) * 128 + 8 * ci + j], bm = BMID[8 * ci + j];
                const float e1 = __builtin_amdgcn_exp2f(fminf(bb - bm, 80.0f) * LOG2E), e2 = __builtin_amdgcn_exp2f(fminf(bm - bb, 80.0f) * LOG2E);
                const float qq = bfel(pq[i], j); qv[j] = qq * e1; kv[j] = kf_[8 * i + j] * e2; qs[j] = qq * __builtin_amdgcn_exp2f((bb + BSC[8 * ci + j]) * LOG2E); }
            *(bf16x8*)(qpp + (size_t)(tok0 + ch * 64 + et) * DH + h * 128 + 8 * ci) = __builtin_bit_cast(bf16x8, __builtin_convertvector(qs, bf16x8_t));
            *(LAS bf16x8*)(L + HG_QT + HSWZ(et, ci)) = __builtin_bit_cast(bf16x8, __builtin_convertvector(qv, bf16x8_t));
            *(LAS bf16x8*)(L + HG_KT + HSWZ(et, ci)) = __builtin_bit_cast(bf16x8, __builtin_convertvector(kv, bf16x8_t)); }
#pragma unroll
        for (int tile = 0; tile < 2; ++tile) { const int kt = 2 * tt + tile; f32x16 sm;
#pragma unroll
            for (int i = 0; i < 16; ++i) { const int kp = 32 * kt + (i & 3) + 4 * ((i >> 2) & 1) + 8 * h2 + 16 * (i >> 3); sm[i] = (tile == 0 ? S0[i] : S1[i]) * EMID[kp]; }
            *(LAS bf16x8*)(L + HG_SM + ((kt * 4 + vt) * 2 + 0) * 1024 + lane * 16) = PACK8(sm, 0);
            *(LAS bf16x8*)(L + HG_SM + ((kt * 4 + vt) * 2 + 1) * 1024 + lane * 16) = PACK8(sm, 1); }
        if (ch + 1 < SEQ / 64) { const bf16* nrow = crow_ + (size_t)64 * DPROJ;
#pragma unroll
            for (int i = 0; i < 2; ++i) { pq[i] = *(const v4u*)(nrow + C_HQ + 8 * (ec + 8 * i)); pf[i] = *(const v4u*)(nrow + C_HF + 8 * (ec + 8 * i)); pv[i] = *(const v4u*)(nrow + C_HI + 8 * (ec + 8 * i)); } }
        __syncthreads();
        bf16x8 qfr[8];
#pragma unroll
        for (int s = 0; s < 8; ++s) qfr[s] = *(const LAS bf16x8*)(L + HG_QT + HSWZ(32 * tt + c, 2 * s + h2));
        f32x16 O;
#pragma unroll
        for (int i = 0; i < 16; ++i) O[i] = 0.f;
#pragma unroll
        for (int st = 0; st < 2; ++st) {
            if (st <= tt) {
                f32x16 x1;
#pragma unroll
                for (int i = 0; i < 16; ++i) x1[i] = 0.f;
#pragma unroll
                for (int s = 0; s < 8; ++s) { const bf16x8 kfr = *(const LAS bf16x8*)(L + HG_KT + HSWZ(32 * st + c, 2 * s + h2)); x1 = MFMA32(kfr, qfr[s], x1); }
                if (st == tt) {
#pragma unroll
                    for (int i = 0; i < 16; ++i) x1[i] = (crow(i, h2) <= c) ? x1[i] : 0.f; }
#pragma unroll
                for (int s = 0; s < 2; ++s) {
                    const bf16x8 pfr = PACK8(x1, s);
                    const s16x4 v0 = TR16(L + HG_VV + HSWZ(32 * st + 16 * s + 4 * h2 + q4, 4 * vt + 2 * blk + (p4 >> 1)) + 8 * (p4 & 1));
                    const s16x4 v1 = TR16(L + HG_VV + HSWZ(32 * st + 16 * s + 8 + 4 * h2 + q4, 4 * vt + 2 * blk + (p4 >> 1)) + 8 * (p4 & 1));
                    O = MFMA32(pfr, __builtin_shufflevector(v0, v1, 0, 1, 2, 3, 4, 5, 6, 7), O);
                }
            }
        }
#pragma unroll
        for (int kt = 0; kt < 4; ++kt)
#pragma unroll
            for (int s = 0; s < 2; ++s) { const bf16x8 smf = *(const LAS bf16x8*)(L + HG_SM + ((kt * 4 + vt) * 2 + s) * 1024 + lane * 16); O = MFMA32(qfr[2 * kt + s], smf, O); }
#pragma unroll
        for (int tile = 0; tile < 2; ++tile) { const int kt = 2 * tt + tile; f32x16 wv;
#pragma unroll
            for (int i = 0; i < 16; ++i) wv[i] = 0.f;
#pragma unroll
            for (int s = 0; s < 4; ++s) {
                const s16x4 a0 = TR16(L + HG_KT + HSWZ(16 * s + 8 * h2 + q4, 4 * kt + 2 * blk + (pe >> 1)) + 8 * (pe & 1));
                const s16x4 a1 = TR16(L + HG_KT + HSWZ(16 * s + 8 * h2 + 4 + q4, 4 * kt + 2 * blk + (pe >> 1)) + 8 * (pe & 1));
                const s16x4 b0 = TR16(L + HG_VV + HSWZ(16 * s + 8 * h2 + q4, 4 * vt + 2 * blk + (p4 >> 1)) + 8 * (p4 & 1));
                const s16x4 b1 = TR16(L + HG_VV + HSWZ(16 * s + 8 * h2 + 4 + q4, 4 * vt + 2 * blk + (p4 >> 1)) + 8 * (p4 & 1));
                wv = MFMA32(__builtin_shufflevector(a0, a1, 0, 1, 2, 3, 4, 5, 6, 7), __builtin_shufflevector(b0, b1, 0, 1, 2, 3, 4, 5, 6, 7), wv);
            }
#pragma unroll
            for (int i = 0; i < 16; ++i) { const int kp = 32 * kt + (i & 3) + 4 * ((i >> 2) & 1) + 8 * h2 + 16 * (i >> 3); const float d = DLAST[kp], cf = CFAC[kp];
                if (tile == 0) S0[i] = d * S0[i] + cf * wv[i]; else S1[i] = d * S1[i] + cf * wv[i]; } }
#pragma unroll
        for (int i = 0; i < 16; ++i) LB[(32 * tt + crow(i, h2)) * 128 + 32 * vt + c] = O[i];
        __syncthreads();
        { bf16* orow = oa + (size_t)(tok0 + ch * 64 + et) * DH + h * 128;
#pragma unroll
          for (int i = 0; i < 4; ++i) { const f32x4 o4 = *(const LAS f32x4*)(LB + et * 128 + 4 * ec + 32 * i);
              *(v2u*)(orow + 4 * ec + 32 * i) = __builtin_bit_cast(v2u, __builtin_convertvector(o4, bf16x4_t)); } }
        __syncthreads();
    }
    { float* ss = (float*)(a.ws + WS_SEGS) + (size_t)item * 16384 + (size_t)w * 2048;
#pragma unroll
      for (int i = 0; i < 16; ++i) { ss[i * 64 + lane] = S0[i]; ss[1024 + i * 64 + lane] = S1[i]; }
      if (tid < 128) ((float*)(a.ws + WS_SEGD))[item * 128 + tid] = __builtin_amdgcn_exp2f(BSV[tid] * LOG2E); }
    __syncthreads();
}

__device__ __forceinline__ void hgrn_fixup(const Args& a, const Frame& F, int item) {
    const int seg = item & 7, h = (item >> 3) & 3, b = item >> 5;
    const bf16* proj = (const bf16*)(a.ws + WS_PROJ); const bf16* oa = (const bf16*)(a.ws + WS_OA); const bf16* qpp = (const bf16*)(a.ws + WS_QPP); bf16* mix = (bf16*)(a.ws + WS_MIX);
    LAS unsigned char* L = F.lds;
    const int tid = F.tid, lane = F.lane, w = F.wave, tt = w >> 2, vt = w & 3, c = lane & 31, h2 = lane >> 5;
    const int et = tid >> 3, ec = tid & 7;
    LAS float* LB = (LAS float*)(L + HG_LB); LAS float* GNV = (LAS float*)(L + HG_GNV);
    if (tid < 128) GNV[tid] = a.hgrn_g[h * 128 + tid];
    f32x16 S0, S1;
#pragma unroll
    for (int i = 0; i < 16; ++i) { S0[i] = 0.f; S1[i] = 0.f; }
#pragma unroll 4
    for (int sg = 0; sg < seg; ++sg) { const int it2 = (item & ~7) + sg;
        const float* ss = (const float*)(a.ws + WS_SEGS) + (size_t)it2 * 16384 + (size_t)w * 2048; const float* dd = (const float*)(a.ws + WS_SEGD) + it2 * 128;
#pragma unroll
        for (int i = 0; i < 16; ++i) { const int kl = (i & 3) + 4 * ((i >> 2) & 1) + 8 * h2 + 16 * (i >> 3);
            S0[i] = dd[32 * (2 * tt) + kl] * S0[i] + ss[i * 64 + lane]; S1[i] = dd[32 * (2 * tt + 1) + kl] * S1[i] + ss[1024 + i * 64 + lane]; } }
    *(LAS bf16x8*)(L + HG_SM + (((2 * tt) * 4 + vt) * 2 + 0) * 1024 + lane * 16) = PACK8(S0, 0); *(LAS bf16x8*)(L + HG_SM + (((2 * tt) * 4 + vt) * 2 + 1) * 1024 + lane * 16) = PACK8(S0, 1);
    *(LAS bf16x8*)(L + HG_SM + (((2 * tt + 1) * 4 + vt) * 2 + 0) * 1024 + lane * 16) = PACK8(S1, 0); *(LAS bf16x8*)(L + HG_SM + (((2 * tt + 1) * 4 + vt) * 2 + 1) * 1024 + lane * 16) = PACK8(S1, 1);
    __syncthreads();
    bf16x8 smf[8];
#pragma unroll
    for (int i = 0; i < 8; ++i) smf[i] = *(const LAS bf16x8*)(L + HG_SM + (((i >> 1) * 4 + vt) * 2 + (i & 1)) * 1024 + lane * 16);
    const int tok0 = b * SEQ + seg * (SEQ / HG_NSEG);
    v2u pg[4], po[4]; bf16x8 qfr[8];
#pragma unroll
    for (int i = 0; i < 8; ++i) qfr[i] = (bf16x8){0, 0, 0, 0, 0, 0, 0, 0};
#define FX_LOAD(tokc_) do { _Pragma("unroll") for (int i = 0; i < 4; ++i) { pg[i] = *(const v2u*)(proj + (size_t)((tokc_) + et) * DPROJ + C_HG + h * 128 + 4 * ec + 32 * i); po[i] = *(const v2u*)(oa + (size_t)((tokc_) + et) * DH + h * 128 + 4 * ec + 32 * i); } \
        if (seg > 0) { const bf16* qp = qpp + (size_t)((tokc_) + 32 * tt + c) * DH + h * 128 + 8 * h2; _Pragma("unroll") for (int i = 0; i < 8; ++i) qfr[i] = *(const bf16x8*)(qp + 16 * i); } } while (0)
    FX_LOAD(tok0);
#pragma unroll 1
    for (int ch = 0; ch < HG_SEGCH; ++ch) {
        const int tokc = tok0 + ch * 64;
        f32x16 O;
#pragma unroll
        for (int i = 0; i < 16; ++i) O[i] = 0.f;
        if (seg > 0) {
#pragma unroll
            for (int i = 0; i < 8; ++i) O = MFMA32(qfr[i], smf[i], O);
        }
        v2u cg[4], co[4];
#pragma unroll
        for (int i = 0; i < 4; ++i) { cg[i] = pg[i]; co[i] = po[i]; }
        if (ch + 1 < HG_SEGCH) FX_LOAD(tokc + 64);
#pragma unroll
        for (int i = 0; i < 16; ++i) LB[(32 * tt + crow(i, h2)) * 128 + 32 * vt + c] = O[i];
        __syncthreads();
        { f32x4 o4[4]; float ssq = 0.f;
#pragma unroll
          for (int i = 0; i < 4; ++i) { o4[i] = *(const LAS f32x4*)(LB + et * 128 + 4 * ec + 32 * i);
              o4[i].x += bflo(co[i].x); o4[i].y += bfhi(co[i].x); o4[i].z += bflo(co[i].y); o4[i].w += bfhi(co[i].y);
              ssq += (o4[i].x * o4[i].x + o4[i].y * o4[i].y) + (o4[i].z * o4[i].z + o4[i].w * o4[i].w); }
          ssq += __shfl_xor(ssq, 1); ssq += __shfl_xor(ssq, 2); ssq += __shfl_xor(ssq, 4);
          const float rn = 1.0f / sqrtf(ssq * (1.0f / 128.0f) + EPS);
          bf16* orow = mix + (size_t)(tokc + et) * DM + h * 128;
#pragma unroll
          for (int i = 0; i < 4; ++i) { const f32x4 gn = *(const LAS f32x4*)(GNV + 4 * ec + 32 * i);
              const float g0 = bflo(cg[i].x), g1 = bfhi(cg[i].x), g2 = bflo(cg[i].y), g3 = bfhi(cg[i].y);
              const float s0 = g0 * __builtin_amdgcn_rcpf(1.0f + __builtin_amdgcn_exp2f(-g0 * LOG2E)), s1 = g1 * __builtin_amdgcn_rcpf(1.0f + __builtin_amdgcn_exp2f(-g1 * LOG2E));
              const float s2 = g2 * __builtin_amdgcn_rcpf(1.0f + __builtin_amdgcn_exp2f(-g2 * LOG2E)), s3 = g3 * __builtin_amdgcn_rcpf(1.0f + __builtin_amdgcn_exp2f(-g3 * LOG2E));
              const bf16x4_t ov = __builtin_convertvector((f32x4){o4[i].x * rn * gn.x * s0, o4[i].y * rn * gn.y * s1, o4[i].z * rn * gn.z * s2, o4[i].w * rn * gn.w * s3}, bf16x4_t);
              *(v2u*)(orow + 4 * ec + 32 * i) = __builtin_bit_cast(v2u, ov); } }
        __syncthreads();
    }
#undef FX_LOAD
}

#ifndef FAST_HGRN
#define FAST_HGRN 1
#endif
__device__ __forceinline__ void phase2(const Args& a, const Frame& F) {
    const bool attn_first = false;
#pragma unroll 1
    for (int step = 0; step < 2; ++step) {
        Frame F2 = F; { int t_ = F.tid; asm volatile("" : "+v"(t_)); F2.tid = t_; F2.lane = t_ & 63; }
        if ((step == 0) == attn_first) { if (!((PROBE_SKIP & 1) && a.li == 1)) attn_items(a, F2); }
        else { for (int it = F.bid; it < NBATCH * 4 * HG_NSEG; it += F.G) hgrn_chunked(a, F2, it); }
    }
}
__device__ __forceinline__ void phase2b(const Args& a, const Frame& F) {
    if (!((PROBE_SKIP & 2) && a.li == 1)) for (int it = F.bid; it < NBATCH * 4 * HG_NSEG; it += F.G) hgrn_fixup(a, F, it);
    if (!((PROBE_SKIP & 4) && a.li == 1)) attn_combine(a, F);
}

__device__ __forceinline__ void phase3(const Args& a, const Frame& F) {
    const bf16* mix = (const bf16*)(a.ws + WS_MIX); const bf16* wout = (const bf16*)(a.ws + WS_WOUT);
#if FAST_GEMM
    { pg8::DenseSched S{mix, wout, NT / 256, DM / 256, F.G, F.bid, DM * 2}; pg8::EpiRes E{a.x, a.out}; pg8::gemm_phase<pg8::EpiRes, pg8::DenseSched, true>(F.lds, DM * 2, S, E, a.ws); return; }
#endif
    constexpr int NPN = DM / 128, NU = (NT / 256) * NPN;
    for (int u = F.bid; u < NU; u += F.G) {
        const int pm = u / NPN, pn = u % NPN;
        const bf16* A0 = mix + (size_t)pm * 256 * DM;
        auto rp = [&](int r) { return A0 + (size_t)r * DM; };
        const float* X = a.x + (size_t)pm * 256 * DM + pn * 128; float* O = a.out + (size_t)pm * 256 * DM + pn * 128;
        auto epi = [&](int r, int c, const f32x4& v) { const f32x4 xv = *(const f32x4*)(X + (size_t)r * DM + c); *(f32x4*)(O + (size_t)r * DM + c) = xv + v; };
        gemm_unit_simple(rp, wout + (size_t)pn * 128 * DM, DM, epi, F.wave, F.lane);
    }
}

__device__ __forceinline__ void phase4(const Args& a, const Frame& F) {
    LAS float* WrT = (LAS float*)F.lds;
    LAS unsigned* hist = (LAS unsigned*)(F.lds + 131072);
    for (int i = F.tid; i < DM * NE / 4; i += NTHR) { const f32x4 w = ((const f32x4*)a.router_w)[i]; const int k = i >> 3, e0 = (i & 7) * 4;
        WrT[(e0 + 0) * DM + k] = w.x; WrT[(e0 + 1) * DM + k] = w.y; WrT[(e0 + 2) * DM + k] = w.z; WrT[(e0 + 3) * DM + k] = w.w; }
    if (F.tid < 32) hist[F.tid] = 0u;
    __syncthreads();
    bf16* h2 = (bf16*)(a.ws + WS_XN); int* topi = (int*)(a.ws + WS_TOPI); float* gate = (float*)(a.ws + WS_GATE);
    const int TPB = (NT + F.G - 1) / F.G; const int lane = F.lane;
    for (int tt = F.wave; tt < TPB; tt += NWAVES) {
        const int t = F.bid * TPB + tt; if (t >= NT) break;
        const f32x4* xr = (const f32x4*)(a.out + (size_t)t * DM) + lane; const f32x4* gr = (const f32x4*)a.norm2_g + lane;
        f32x4 hv[4]; float s = 0.f;
#pragma unroll
        for (int j = 0; j < 4; ++j) { hv[j] = xr[64 * j]; s += (hv[j].x * hv[j].x + hv[j].y * hv[j].y) + (hv[j].z * hv[j].z + hv[j].w * hv[j].w); }
        const float r = 1.0f / sqrtf(wave_sum(s) * (1.f / DM) + EPS);
        v2u* o8 = (v2u*)(h2 + (size_t)t * DM) + lane;
#pragma unroll
        for (int j = 0; j < 4; ++j) { const f32x4 g = gr[64 * j]; hv[j].x *= r * g.x; hv[j].y *= r * g.y; hv[j].z *= r * g.z; hv[j].w *= r * g.w;
            v2u w; w.x = pk2(hv[j].x, hv[j].y); w.y = pk2(hv[j].z, hv[j].w); o8[64 * j] = w; }
        float pv[32];
#pragma unroll
        for (int e = 0; e < 32; ++e) { float acc = 0.f;
#pragma unroll
            for (int j = 0; j < 4; ++j) { const f32x4 w = *(const LAS f32x4*)(WrT + e * DM + 4 * lane + 256 * j); acc += (hv[j].x * w.x + hv[j].y * w.y) + (hv[j].z * w.z + hv[j].w * w.w); }
            pv[e] = acc; }
#define RS_STEP(OFF, N) { const bool up = (lane & (OFF)) != 0; _Pragma("unroll") for (int i = 0; i < (N); ++i) { const float send = up ? pv[i] : pv[i + (N)]; const float keep = up ? pv[i + (N)] : pv[i]; pv[i] = keep + __shfl_xor(send, (OFF)); } }
        RS_STEP(32, 16) RS_STEP(16, 8) RS_STEP(8, 4) RS_STEP(4, 2) RS_STEP(2, 1)
#undef RS_STEP
        float lg = pv[0] + __shfl_xor(pv[0], 1);
        const int me = lane >> 1; lg += a.router_b[me];
        float tv[4]; int ti[4]; float cur = lg;
#pragma unroll
        for (int k = 0; k < 4; ++k) { float bv = cur; int bi = me;
#pragma unroll
            for (int o = 1; o < 64; o <<= 1) { const float ov = __shfl_xor(bv, o); const int oi = __shfl_xor(bi, o); const bool tk = (ov > bv) | ((ov == bv) & (oi < bi)); bv = tk ? ov : bv; bi = tk ? oi : bi; }
            tv[k] = bv; ti[k] = bi; if (me == bi) cur = -INFINITY; }
        const float e1 = __expf(tv[1] - tv[0]), e2 = __expf(tv[2] - tv[0]), e3 = __expf(tv[3] - tv[0]); const float inv = 1.0f / (1.0f + e1 + e2 + e3);
        if (lane == 0) { *(int4*)(topi + (size_t)t * 4) = make_int4(ti[0], ti[1], ti[2], ti[3]); *(f32x4*)(gate + (size_t)t * 4) = (f32x4){inv, e1 * inv, e2 * inv, e3 * inv}; }
        if (lane < 4) { const int e = lane == 0 ? ti[0] : lane == 1 ? ti[1] : lane == 2 ? ti[2] : ti[3]; atomicAdd((unsigned*)&hist[e], 1u); }
    }
    __syncthreads();
    if (F.tid < 32) ((int*)(a.ws + WS_BC))[F.bid * 32 + F.tid] = (int)hist[F.tid];
    __syncthreads();
}

__device__ __forceinline__ void phase4_mfma(const Args& a, const Frame& F) {
    LAS float* WG = (LAS float*)F.lds;
    LAS unsigned* hist = (LAS unsigned*)(F.lds + 131072);
    for (int i = F.tid; i < DM * NE / 4; i += NTHR) { const f32x4 wv = ((const f32x4*)a.router_w)[i]; const float g = a.norm2_g[i >> 3]; *(LAS f32x4*)(WG + 4 * i) = wv * g; }
    if (F.tid < 32) hist[F.tid] = 0u;
    __syncthreads();
    bf16* h2 = (bf16*)(a.ws + WS_XN); int* topi = (int*)(a.ws + WS_TOPI); float* gate = (float*)(a.ws + WS_GATE);
    const int TPB = (NT + F.G - 1) / F.G; const int lane = F.lane;
    if (F.wave < 4) {
        const int tokl = lane & 31, half = lane >> 5;
        for (int j = F.wave; j * 32 < TPB; j += 4) {
            const int t = F.bid * TPB + j * 32 + tokl; if (F.bid * TPB + j * 32 >= NT) break;
            const float* xrow = a.out + (size_t)t * DM + 4 * half;
            f32x16 acc;
#pragma unroll
            for (int i = 0; i < 16; ++i) acc[i] = 0.f;
            float ss = 0.f;
#pragma unroll 8
            for (int m = 0; m < 128; ++m) { const f32x4 xv = *(const f32x4*)(xrow + 8 * m); ss += (xv.x * xv.x + xv.y * xv.y) + (xv.z * xv.z + xv.w * xv.w);
                const LAS float* wp = WG + (8 * m + 4 * half) * 32 + tokl;
                acc = __builtin_amdgcn_mfma_f32_32x32x2f32(wp[0], xv.x, acc, 0, 0, 0); acc = __builtin_amdgcn_mfma_f32_32x32x2f32(wp[32], xv.y, acc, 0, 0, 0);
                acc = __builtin_amdgcn_mfma_f32_32x32x2f32(wp[64], xv.z, acc, 0, 0, 0); acc = __builtin_amdgcn_mfma_f32_32x32x2f32(wp[96], xv.w, acc, 0, 0, 0); }
            ss += __shfl_xor(ss, 32);
            const float r = 1.0f / sqrtf(ss * (1.f / DM) + EPS);
            float v[16];
#pragma unroll
            for (int i = 0; i < 16; ++i) v[i] = acc[i] * r + a.router_b[crow(i, half)];
            float tv[8]; int ti[8];
#pragma unroll
            for (int k = 0; k < 4; ++k) { float bv = -INFINITY; int bi = 0;
#pragma unroll
                for (int i = 0; i < 16; ++i) { const bool tk = v[i] > bv; bv = tk ? v[i] : bv; bi = tk ? i : bi; }
#pragma unroll
                for (int i = 0; i < 16; ++i) v[i] = (i == bi) ? -INFINITY : v[i];
                tv[k] = bv; ti[k] = (bi & 3) + 8 * (bi >> 2) + 4 * half; }
#pragma unroll
            for (int k = 0; k < 4; ++k) { tv[4 + k] = __shfl_xor(tv[k], 32); ti[4 + k] = __shfl_xor(ti[k], 32); }
            float gv[4]; int gi[4];
#pragma unroll
            for (int k = 0; k < 4; ++k) { float bv = -INFINITY; int bi = 1 << 30; int bs = 0;
#pragma unroll
                for (int i = 0; i < 8; ++i) { const bool tk = (tv[i] > bv) | ((tv[i] == bv) & (ti[i] < bi)); bv = tk ? tv[i] : bv; bi = tk ? ti[i] : bi; bs = tk ? i : bs; }
#pragma unroll
                for (int i = 0; i < 8; ++i) tv[i] = (i == bs) ? -INFINITY : tv[i];
                gv[k] = bv; gi[k] = bi; }
            const float e1 = __expf(gv[1] - gv[0]), e2 = __expf(gv[2] - gv[0]), e3 = __expf(gv[3] - gv[0]); const float inv = 1.0f / (1.0f + e1 + e2 + e3);
            if (half == 0) { *(int4*)(topi + (size_t)t * 4) = make_int4(gi[0], gi[1], gi[2], gi[3]); *(f32x4*)(gate + (size_t)t * 4) = (f32x4){inv, e1 * inv, e2 * inv, e3 * inv};
#pragma unroll
                for (int k = 0; k < 4; ++k) atomicAdd((unsigned*)&hist[gi[k]], 1u); }
        }
    } else {
        for (int tt = F.wave - 4; tt < TPB; tt += 4) {
            const int t = F.bid * TPB + tt; if (t >= NT) break;
            const f32x4* xr = (const f32x4*)(a.out + (size_t)t * DM) + lane; const f32x4* gr = (const f32x4*)a.norm2_g + lane;
            f32x4 hv[4]; float s = 0.f;
#pragma unroll
            for (int j = 0; j < 4; ++j) { hv[j] = xr[64 * j]; s += (hv[j].x * hv[j].x + hv[j].y * hv[j].y) + (hv[j].z * hv[j].z + hv[j].w * hv[j].w); }
            const float r = 1.0f / sqrtf(wave_sum(s) * (1.f / DM) + EPS);
            v2u* o8 = (v2u*)(h2 + (size_t)t * DM) + lane;
#pragma unroll
            for (int j = 0; j < 4; ++j) { const f32x4 g = gr[64 * j];
                if (MOE_FP8) ((unsigned*)((unsigned char*)h2 + (size_t)t * DM))[lane + 64 * j] = pk4_fp8(hv[j].x * r * g.x, hv[j].y * r * g.y, hv[j].z * r * g.z, hv[j].w * r * g.w);
                else { const bf16x4_t hb = __builtin_convertvector((f32x4){hv[j].x * r * g.x, hv[j].y * r * g.y, hv[j].z * r * g.z, hv[j].w * r * g.w}, bf16x4_t); o8[64 * j] = __builtin_bit_cast(v2u, hb); } }
        }
    }
    __syncthreads();
    if (F.tid < 32) ((int*)(a.ws + WS_BC))[F.bid * 32 + F.tid] = (int)hist[F.tid];
    __syncthreads();
}

__device__ __forceinline__ void phase5(const Args& a, const Frame& F) {
    LAS int* cnt = (LAS int*)F.lds; LAS int* base = cnt + 32; LAS int* pstart = cnt + 64; LAS unsigned* cursor = (LAS unsigned*)(cnt + 128);
    const int* BC = (const int*)(a.ws + WS_BC);
    if (F.tid < 32) { int total = 0, before = 0; for (int b = 0; b < F.G; ++b) { const int c = BC[b * 32 + F.tid]; total += c; if (b < F.bid) before += c; } cnt[F.tid] = total; base[F.tid] = before; cursor[F.tid] = 0u; }
    __syncthreads();
    if (F.tid == 0) { int ps = 0; for (int e = 0; e < 32; ++e) { pstart[e] = ps; ps += (cnt[e] + 255) & ~255; } pstart[32] = ps; }
    __syncthreads();
    const int* topi = (const int*)(a.ws + WS_TOPI); int* dest = (int*)(a.ws + WS_DEST); int* rowtok = (int*)(a.ws + WS_ROWTOK);
    const int TPB = (NT + F.G - 1) / F.G;
    LAS int* dl = cnt + 256;
    for (int i = F.tid; i < TPB * 4; i += NTHR) { const int t = F.bid * TPB + (i >> 2); int d = -1; if (t < NT) { const int e = topi[(size_t)t * 4 + (i & 3)];
        const unsigned slot = atomicAdd((unsigned*)&cursor[e], 1u); d = pstart[e] + base[e] + (int)slot; dest[(size_t)t * 4 + (i & 3)] = d; rowtok[d] = t; }
        if (i < 2048) dl[i] = d; }
    if (MOE_FP8) {
        __syncthreads();
        const unsigned char* h2b = (const unsigned char*)(a.ws + WS_XN); unsigned char* xb = (unsigned char*)(a.ws + WS_XBUF);
        const int np = (TPB * 4 < 2048) ? TPB * 4 : 2048;
        for (int tl = F.wave; tl < TPB; tl += 4 * NWAVES) {
            v4u w[4]; int dd[4][4];
#pragma unroll
            for (int q = 0; q < 4; ++q) { const int tq = tl + q * NWAVES; const int t = F.bid * TPB + (tq < TPB ? tq : tl);
                w[q] = *(const v4u*)(h2b + (size_t)t * DM + 16 * F.lane);
#pragma unroll
                for (int k = 0; k < 4; ++k) dd[q][k] = (tq < TPB && 4 * tq + k < np) ? dl[4 * tq + k] : -1; }
#pragma unroll
            for (int q = 0; q < 4; ++q)
#pragma unroll
                for (int k = 0; k < 4; ++k) if (dd[q][k] >= 0) *(v4u*)(xb + (size_t)dd[q][k] * DM + 16 * F.lane) = w[q];
        }
    }
    if (F.bid == 0) {
        const int e = F.tid >> 4; const int pe = (cnt[e] + 255) & ~255;
        for (int r = cnt[e] + (F.tid & 15); r < pe; r += 16) rowtok[pstart[e] + r] = 0;
        if (F.tid < 32) ((int*)(a.ws + WS_CNT))[F.tid] = cnt[F.tid];
    }
    __syncthreads();
}

__device__ __forceinline__ int moe_tiles(const Args& a, const Frame& F, LAS int* tstart) {
    if (F.tid == 0) { const int* cnt = (const int*)(a.ws + WS_CNT); int ts = 0; for (int e = 0; e < 32; ++e) { tstart[e] = ts; ts += (cnt[e] + 255) >> 8; } tstart[32] = ts; }
    __syncthreads();
    return tstart[32];
}
__device__ __forceinline__ int tile_expert(const LAS int* tstart, int rt) { int e = 0;
#pragma unroll 1
    for (int i = 1; i < 32; ++i) if (rt >= tstart[i]) e = i;
    return e; }

__device__ __forceinline__ void phase6(const Args& a, const Frame& F) {
    LAS int* tstart = (LAS int*)(F.lds + 131072);
    const int TM = moe_tiles(a, F, tstart);
    const bf16* h2 = (const bf16*)(a.ws + WS_XN); const bf16* wup = (const bf16*)(a.ws + WS_WUP); bf16* act = (bf16*)(a.ws + WS_ACT); const int* rowtok = (const int*)(a.ws + WS_ROWTOK);
#if FAST_GEMM
    { constexpr int EB = MOE_FP8 ? 1 : 2;
      pg8::EpiSwiglu E{act, a.b_up, tstart};
      if constexpr (MOE_FP8) { pg8::MoeSched<false> S{a.ws + WS_XBUF, wup, rowtok, tstart, TM, DUP / 256, F.G, F.bid, DM * EB, (size_t)DUP * DM * EB};
          pg8::gemm_phase<pg8::EpiSwiglu, pg8::MoeSched<false>, true, true>(F.lds, DM * EB, S, E, a.ws); }
      else { pg8::MoeSched<true> S{h2, wup, rowtok, tstart, TM, DUP / 256, F.G, F.bid, DM * EB, (size_t)DUP * DM * EB};
          pg8::gemm_phase<pg8::EpiSwiglu, pg8::MoeSched<true>, true, false>(F.lds, DM * EB, S, E, a.ws); }
      return; }
#endif
    constexpr int NPN = DUP / 128; const int NU = TM * NPN;
    for (int u = F.bid; u < NU; u += F.G) {
        const int rt = u / NPN, pn = u % NPN; const int e = tile_expert(tstart, rt);
        const int* rtk = rowtok + (size_t)rt * 256;
        auto rp = [&](int r) { return h2 + (size_t)rtk[r] * DM; };
        const float* bias = a.b_up + (size_t)e * DUP + pn * 128; bf16* O = act + (size_t)rt * 256 * DEXP + pn * 64;
        auto epi = [&](int r, int c, const f32x4& v) { const f32x4 bv = *(const f32x4*)(bias + c);
            const float g0 = fminf(v.x + bv.x, 7.0f), l0 = fminf(fmaxf(v.y + bv.y, -7.0f), 7.0f), g1 = fminf(v.z + bv.z, 7.0f), l1 = fminf(fmaxf(v.w + bv.w, -7.0f), 7.0f);
            const float a0 = g0 / (1.0f + __expf(-1.702f * g0)) * (l0 + 1.0f), a1 = g1 / (1.0f + __expf(-1.702f * g1)) * (l1 + 1.0f);
            *(unsigned*)(O + (size_t)r * DEXP + (c >> 1)) = pk2(a0, a1); };
        gemm_unit_simple(rp, wup + (size_t)e * DUP * DM + (size_t)pn * 128 * DM, DM, epi, F.wave, F.lane);
    }
}

__device__ __forceinline__ void phase7(const Args& a, const Frame& F) {
    LAS int* tstart = (LAS int*)(F.lds + 131072);
    const int TM = moe_tiles(a, F, tstart);
    const bf16* act = (const bf16*)(a.ws + WS_ACT); const bf16* wdn = (const bf16*)(a.ws + WS_WDN); bf16* yb = (bf16*)(a.ws + WS_YBUF);
#if FAST_GEMM
    { constexpr int EB = MOE_FP8 ? 1 : 2;
      pg8::MoeSched<false> S{act, wdn, nullptr, tstart, TM, DM / 256, F.G, F.bid, DEXP * EB, (size_t)DM * DEXP * EB}; pg8::EpiY E{yb, a.b_down, tstart};
      pg8::gemm_phase<pg8::EpiY, pg8::MoeSched<false>, true, MOE_FP8>(F.lds, DEXP * EB, S, E, a.ws); return; }
#endif
    constexpr int NPN = DM / 128; const int NU = TM * NPN;
    for (int u = F.bid; u < NU; u += F.G) {
        const int rt = u / NPN, pn = u % NPN; const int e = tile_expert(tstart, rt);
        const bf16* A0 = act + (size_t)rt * 256 * DEXP;
        auto rp = [&](int r) { return A0 + (size_t)r * DEXP; };
        const float* bias = a.b_down + (size_t)e * DM + pn * 128; bf16* O = yb + (size_t)rt * 256 * DM + pn * 128;
        auto epi = [&](int r, int c, const f32x4& v) { const f32x4 bv = *(const f32x4*)(bias + c); v2u w; w.x = pk2(v.x + bv.x, v.y + bv.y); w.y = pk2(v.z + bv.z, v.w + bv.w); *(v2u*)(O + (size_t)r * DM + c) = w; };
        gemm_unit_simple(rp, wdn + (size_t)e * DM * DEXP + (size_t)pn * 128 * DEXP, DEXP, epi, F.wave, F.lane);
    }
}

__device__ __forceinline__ void phase8(const Args& a, const Frame& F) {
    const bf16* yb = (const bf16*)(a.ws + WS_YBUF); const int* dest = (const int*)(a.ws + WS_DEST); const float* gate = (const float*)(a.ws + WS_GATE);
    const int gw = F.bid * NWAVES + F.wave, NGW = F.G * NWAVES, lane = F.lane;
    const f32x4* gr = (const f32x4*)a.final_g + lane;
    f32x4 fg[4];
#pragma unroll
    for (int j = 0; j < 4; ++j) fg[j] = gr[64 * j];
    for (int t = gw; t < NT; t += 2 * NGW) {
        const int t2 = (t + NGW < NT) ? t + NGW : t;
        f32x4* xr = (f32x4*)(a.out + (size_t)t * DM) + lane; f32x4* xr2 = (f32x4*)(a.out + (size_t)t2 * DM) + lane;
        const int4 d4 = *(const int4*)(dest + (size_t)t * 4), e4 = *(const int4*)(dest + (size_t)t2 * 4); const f32x4 g4 = *(const f32x4*)(gate + (size_t)t * 4), h4 = *(const f32x4*)(gate + (size_t)t2 * 4);
        f32x4 v[4], u[4];
#pragma unroll
        for (int j = 0; j < 4; ++j) { v[j] = xr[64 * j]; u[j] = xr2[64 * j]; }
        v2u yv[4][4], yu[4][4];
#pragma unroll
        for (int k = 0; k < 4; ++k) { const int d = k == 0 ? d4.x : k == 1 ? d4.y : k == 2 ? d4.z : d4.w; const int e = k == 0 ? e4.x : k == 1 ? e4.y : k == 2 ? e4.z : e4.w;
            const v2u* yr = (const v2u*)(yb + (size_t)d * DM) + lane; const v2u* yr2 = (const v2u*)(yb + (size_t)e * DM) + lane;
#pragma unroll
            for (int j = 0; j < 4; ++j) { yv[k][j] = yr[64 * j]; yu[k][j] = yr2[64 * j]; } }
#pragma unroll
        for (int k = 0; k < 4; ++k) { const float g = k == 0 ? g4.x : k == 1 ? g4.y : k == 2 ? g4.z : g4.w; const float hq = k == 0 ? h4.x : k == 1 ? h4.y : k == 2 ? h4.z : h4.w;
#pragma unroll
            for (int j = 0; j < 4; ++j) { const v2u w = yv[k][j]; v[j].x += g * bflo(w.x); v[j].y += g * bfhi(w.x); v[j].z += g * bflo(w.y); v[j].w += g * bfhi(w.y);
                const v2u w2 = yu[k][j]; u[j].x += hq * bflo(w2.x); u[j].y += hq * bfhi(w2.x); u[j].z += hq * bflo(w2.y); u[j].w += hq * bfhi(w2.y); } }
        float s = 0.f, s2 = 0.f;
#pragma unroll
        for (int j = 0; j < 4; ++j) { s += (v[j].x * v[j].x + v[j].y * v[j].y) + (v[j].z * v[j].z + v[j].w * v[j].w); s2 += (u[j].x * u[j].x + u[j].y * u[j].y) + (u[j].z * u[j].z + u[j].w * u[j].w); }
        const float r = 1.0f / sqrtf(wave_sum(s) * (1.f / DM) + EPS), r2 = 1.0f / sqrtf(wave_sum(s2) * (1.f / DM) + EPS);
#pragma unroll
        for (int j = 0; j < 4; ++j) { const f32x4 g = fg[j]; xr[64 * j] = (f32x4){v[j].x * r * g.x, v[j].y * r * g.y, v[j].z * r * g.z, v[j].w * r * g.w};
            if (t2 != t) xr2[64 * j] = (f32x4){u[j].x * r2 * g.x, u[j].y * r2 * g.y, u[j].z * r2 * g.z, u[j].w * r2 * g.w}; }
    }
}

__global__ void __launch_bounds__(NTHR, 2) fwd(Args args) {
    extern __shared__ __attribute__((aligned(16))) unsigned char lds[];
    Frame F0; F0.lds = (LAS unsigned char*)lds; F0.tid = threadIdx.x; F0.lane = F0.tid & 63; F0.wave = __builtin_amdgcn_readfirstlane(F0.tid >> 6); F0.G = gridDim.x; F0.bid = blockIdx.x; const Frame& F = F0;
    volatile LAS unsigned* MISC = (volatile LAS unsigned*)(F.lds + MISC_OFF);
    if (F.tid < 32) MISC[F.tid] = 0u;
    __syncthreads();
    XcdBarrier bar; bar.bar = (unsigned*)(args.ws + WS_CTL) + CW_BAR + args.li * XCD_BAR_WORDS; bar.x = 0; bar.st = nullptr;
    if (MK_N_LAUNCHES == 1) bar = xcd_barrier_post((unsigned*)(args.ws + WS_CTL) + CW_BAR + args.li * XCD_BAR_WORDS, MISC + 8);
    const int lo = args.ph_lo, hi = args.ph_hi;
#define IN(k) (lo <= (k) && (k) < hi)
#define SEAM(k) do { if (IN(k) && IN((k) + 1)) xcd_barrier(bar); } while (0)
#ifndef DBL
#define DBL 0
#endif
#define REP(k) for (int rep_ = 0; rep_ < (((DBL) >> (k)) & 1) + 1; ++rep_)
#define FR() ({ Frame f_ = F0; int t_ = threadIdx.x; asm volatile("" : "+v"(t_)); f_.tid = t_; f_.lane = t_ & 63; f_; })
    if (IN(0)) REP(0) { phase0(args, FR()); if (rep_ == 0 && ((DBL >> 0) & 1)) xcd_barrier(bar); } SEAM(0);
    if (IN(1)) REP(1) { phase1(args, FR()); if (rep_ == 0 && ((DBL >> 1) & 1)) xcd_barrier(bar); } SEAM(1);
    if (IN(2)) REP(2) { phase2(args, FR()); if (rep_ == 0 && ((DBL >> 2) & 1)) xcd_barrier(bar); } SEAM(2);
    if (IN(3)) REP(3) { phase2b(args, FR()); if (rep_ == 0 && ((DBL >> 3) & 1)) xcd_barrier(bar); } SEAM(3);
    if (IN(4)) REP(4) { phase3(args, FR()); if (rep_ == 0 && ((DBL >> 4) & 1)) xcd_barrier(bar); } SEAM(4);
    if (IN(5)) REP(5) { phase4_mfma(args, FR()); if (rep_ == 0 && ((DBL >> 5) & 1)) xcd_barrier(bar); } SEAM(5);
    if (IN(6)) REP(6) { phase5(args, FR()); if (rep_ == 0 && ((DBL >> 6) & 1)) xcd_barrier(bar); } SEAM(6);
    if (IN(7)) REP(7) { phase6(args, FR()); if (rep_ == 0 && ((DBL >> 7) & 1)) xcd_barrier(bar); } SEAM(7);
    if (IN(8)) REP(8) { phase7(args, FR()); if (rep_ == 0 && ((DBL >> 8) & 1)) xcd_barrier(bar); } SEAM(8);
    if (IN(9)) phase8(args, FR());
#undef IN
#undef SEAM
}

extern "C" void kernel_launch(void* const* d_in, const int* in_sizes, int n_in, void* d_out, int out_size, void* d_ws, size_t ws_size, hipStream_t stream) {
    static int grid = 0;
    if (grid == 0) {
        if (n_in != 15 || in_sizes[0] != NT * DM || out_size != NT * DM || ws_size < WS_END) { fprintf(stderr, "kernel_launch: shape/workspace mismatch (n_in %d, in0 %d, out %d, ws %zu)\n", n_in, n_in > 0 ? in_sizes[0] : -1, out_size, ws_size); grid = -1; return; }
        int dev = 0, cus = 0;
        if (hipGetDevice(&dev) != hipSuccess || hipDeviceGetAttribute(&cus, hipDeviceAttributeMultiprocessorCount, dev) != hipSuccess) { grid = -1; return; }
        if (hipFuncSetAttribute((const void*)fwd, hipFuncAttributeMaxDynamicSharedMemorySize, LDS_BYTES) != hipSuccess) { fprintf(stderr, "kernel_launch: hipFuncSetAttribute failed\n"); grid = -1; return; }
        int per_cu = 0;
        if (hipOccupancyMaxActiveBlocksPerMultiprocessor(&per_cu, (const void*)fwd, NTHR, LDS_BYTES) != hipSuccess || per_cu < 1) fprintf(stderr, "kernel_launch: occupancy query reports %d\n", per_cu);
        (void)hipGetLastError();
        grid = cus;
    }
    if (grid < 0) return;
    (void)hipMemsetAsync((char*)d_ws + WS_CTL, 0, CTL_ZERO_BYTES, stream);
    Args a{};
    a.x = (const float*)d_in[0]; a.norm1_g = (const float*)d_in[1]; a.w_in = (const float*)d_in[2]; a.lb_logits = (const float*)d_in[3]; a.hgrn_g = (const float*)d_in[4]; a.attn_g = (const float*)d_in[5];
    a.w_out = (const float*)d_in[6]; a.norm2_g = (const float*)d_in[7]; a.router_w = (const float*)d_in[8]; a.router_b = (const float*)d_in[9]; a.w_up = (const float*)d_in[10]; a.b_up = (const float*)d_in[11];
    a.w_down = (const float*)d_in[12]; a.b_down = (const float*)d_in[13]; a.final_g = (const float*)d_in[14];
    a.out = (float*)d_out; a.ws = (unsigned char*)d_ws;
#ifndef PROBE_PH
#define PROBE_PH -1
#endif
    if (PROBE_PH >= 0) {
        a.ph_lo = 0; a.ph_hi = PROBE_PH + 1; a.li = 0; hipLaunchKernelGGL(fwd, dim3(grid), dim3(NTHR), LDS_BYTES, stream, a);
        a.ph_lo = PROBE_PH; a.ph_hi = PROBE_PH + 1; a.li = 1; hipLaunchKernelGGL(fwd, dim3(grid), dim3(NTHR), LDS_BYTES, stream, a);
        a.ph_lo = PROBE_PH + 1; a.ph_hi = NPHASE; a.li = 2; hipLaunchKernelGGL(fwd, dim3(grid), dim3(NTHR), LDS_BYTES, stream, a);
    } else
    if (MK_N_LAUNCHES == 1) { a.ph_lo = 0; a.ph_hi = NPHASE; hipLaunchKernelGGL(fwd, dim3(grid), dim3(NTHR), LDS_BYTES, stream, a); }
    else for (int p = 0; p < NPHASE; ++p) { a.ph_lo = p; a.ph_hi = p + 1; hipLaunchKernelGGL(fwd, dim3(grid), dim3(NTHR), LDS_BYTES, stream, a); }
}
```

```cpp
#include <hip/hip_runtime.h>
#include <cstdio>
#include <cstdint>

#ifndef PROBE_SKIP
#define PROBE_SKIP 0
#endif
#ifndef MOE_FP8
#define MOE_FP8 1
#endif
#ifndef MK_N_LAUNCHES
#define MK_N_LAUNCHES 1
#endif

#define GAS __attribute__((address_space(1)))
#define LAS __attribute__((address_space(3)))
typedef unsigned short bf16;
typedef unsigned v4u __attribute__((ext_vector_type(4)));
typedef unsigned v2u __attribute__((ext_vector_type(2)));
typedef float f32x4 __attribute__((ext_vector_type(4)));
typedef short bf16x8 __attribute__((ext_vector_type(8)));
typedef int v4i __attribute__((ext_vector_type(4)));
typedef int v8i __attribute__((ext_vector_type(8)));

constexpr int NT = 32768, DM = 1024, SEQ = 4096, NBATCH = 8;
constexpr int DH = 512;
constexpr int DPROJ = 3584;
constexpr int C_HQ = 0, C_HF = 512, C_HI = 1024, C_HG = 1536, C_AQ = 2048, C_AK = 2560, C_AV = 3072;
constexpr int NE = 32, DUP = 2048, DEXP = 1024;
constexpr float EPS = 1e-6f;
constexpr int NPHASE = 10;
constexpr int NWAVES = 8, NTHR = 512;
constexpr int RMAX = NT * 4 + NE * 256;

constexpr size_t MiB = 1u << 20;
constexpr size_t WS_CTL = 0, CTL_ZERO_BYTES = 1 * MiB;
constexpr size_t WS_WIN = 1 * MiB;
constexpr size_t WS_WOUT = 8 * MiB;
constexpr size_t WS_WUP = 10 * MiB;
constexpr size_t WS_WDN = 138 * MiB;
constexpr size_t WS_XN = 202 * MiB;
constexpr size_t WS_OA = WS_XN;
constexpr size_t WS_QPP = WS_XN + 32 * MiB;
constexpr size_t WS_MIX = 266 * MiB;
constexpr size_t WS_PROJ = 330 * MiB;
constexpr size_t WS_OP = 554 * MiB;
constexpr size_t WS_ACT = 330 * MiB;
constexpr size_t WS_XBUF = 466 * MiB;
constexpr size_t WS_SMALL = 650 * MiB;
constexpr size_t WS_TOPI = WS_SMALL;
constexpr size_t WS_GATE = WS_SMALL + 1 * MiB;
constexpr size_t WS_DEST = WS_SMALL + 2 * MiB;
constexpr size_t WS_ROWTOK = WS_SMALL + 3 * MiB;
constexpr size_t WS_BC = WS_SMALL + 4 * MiB;
constexpr size_t WS_CNT = WS_SMALL + 5 * MiB;
constexpr size_t WS_BUP = WS_SMALL + 6 * MiB;
constexpr size_t WS_BDN = WS_SMALL + 6 * MiB + 262144;
constexpr size_t WS_YBUF = 658 * MiB;
constexpr size_t WS_LSE = WS_YBUF;
constexpr size_t WS_SEGS = WS_YBUF + 4 * MiB;
constexpr size_t WS_SEGD = WS_YBUF + 20 * MiB;
constexpr size_t WS_KV = 930 * MiB;
constexpr size_t WS_QH = WS_YBUF + 22 * MiB;
constexpr size_t WS_END = 994 * MiB;

constexpr int CW_BAR = 4096;

constexpr int LDS_BYTES = 147456;
constexpr int MISC_OFF = 131072 + 8192;

#define RLX_AGENT __ATOMIC_RELAXED, __HIP_MEMORY_SCOPE_AGENT
__device__ __forceinline__ unsigned f2bf(float f) { unsigned u = __builtin_bit_cast(unsigned, f); return (u + 0x7fffu + ((u >> 16) & 1u)) >> 16; }
__device__ __forceinline__ unsigned pk2(float lo, float hi) { return f2bf(lo) | (f2bf(hi) << 16); }
__device__ __forceinline__ unsigned pk4_fp8(float a, float b, float c, float d) { int w = 0; w = __builtin_amdgcn_cvt_pk_fp8_f32(a, b, w, false); w = __builtin_amdgcn_cvt_pk_fp8_f32(c, d, w, true); return (unsigned)w; }
constexpr float FP8_WSCALE = 64.0f, FP8_WINV = 1.0f / 64.0f;
__device__ __forceinline__ float bf2f(unsigned h) { return __builtin_bit_cast(float, h << 16); }
__device__ __forceinline__ float bflo(unsigned w) { return __builtin_bit_cast(float, w << 16); }
__device__ __forceinline__ float bfhi(unsigned w) { return __builtin_bit_cast(float, w & 0xffff0000u); }
#define RL(x, i) __builtin_bit_cast(float, __builtin_amdgcn_readlane(__builtin_bit_cast(int, (x)), (i)))
__device__ __forceinline__ float wave_sum(float v) {
#pragma unroll
    for (int o = 1; o < 64; o <<= 1) v += __shfl_xor(v, o);
    return v;
}
__device__ __forceinline__ float wave_max(float v) {
#pragma unroll
    for (int o = 1; o < 64; o <<= 1) v = fmaxf(v, __shfl_xor(v, o));
    return v;
}

#define XB_TMO      128
#define XB_XCNT(j)  (256  + 64 * (j))
#define XB_XSUB(j)  (1280 + 64 * (j))
#define XB_XGEN(j)  (2304 + 64 * (j))
#define XB_TOP      3328
#define XB_TOPGEN   3392
#define XCD_BAR_WORDS 3456
#define XB_SPIN_CAP (1u << 22)
__device__ __forceinline__ unsigned xb_ld(unsigned* p)              { return __hip_atomic_load(p, __ATOMIC_RELAXED, __HIP_MEMORY_SCOPE_AGENT); }
__device__ __forceinline__ unsigned xb_add(unsigned* p, unsigned v) { return __hip_atomic_fetch_add(p, v, __ATOMIC_RELAXED, __HIP_MEMORY_SCOPE_AGENT); }
__device__ __forceinline__ unsigned xb_xcc_id() { return (unsigned)__builtin_amdgcn_s_getreg((3 << 11) | 20) & 0xFu; }
#define XB_SPIN(cond, bar) do { unsigned _sp = 0; while (cond) { __builtin_amdgcn_s_sleep(1); \
    if ((++_sp & 255u) == 0u) { if (xb_ld(&(bar)[XB_TMO])) break; if (_sp > XB_SPIN_CAP) { atomicAdd(&(bar)[XB_TMO], 1u); break; } } } } while (0)
struct XcdBarrier { unsigned* bar; unsigned x; volatile LAS unsigned* st; };
__device__ __forceinline__ XcdBarrier xcd_barrier_post(unsigned* bar, volatile LAS unsigned* st) {
    XcdBarrier b; b.bar = bar; b.x = xb_xcc_id(); b.st = st;
    if (threadIdx.x == 0) (void)xb_add(&bar[XB_XCNT(b.x)], 1u);
    return b;
}
__device__ __forceinline__ void xcd_barrier_complete(unsigned* bar, unsigned x, unsigned& nloc, unsigned& nx) {
    const unsigned G = gridDim.x * gridDim.y * gridDim.z;
    unsigned sum, cnt, mine, sp = 0u;
    for (;;) {
        sum = 0u; cnt = 0u; mine = 0u;
#pragma unroll
        for (unsigned j = 0; j < 16; ++j) { const unsigned c = xb_ld(&bar[XB_XCNT(j)]); sum += c; cnt += (c > 0u) ? 1u : 0u; mine = (j == x) ? c : mine; }
        if (sum == G) break;
        __builtin_amdgcn_s_sleep(1);
        if ((++sp & 255u) == 0u) { if (xb_ld(&bar[XB_TMO])) break; if (sp > XB_SPIN_CAP) { atomicAdd(&bar[XB_TMO], 1u); break; } }
    }
    nloc = mine > 0u ? mine : 1u; nx = cnt > 0u ? cnt : 1u;
}
__device__ __forceinline__ void xcd_barrier(const XcdBarrier& b) {
    asm volatile("s_waitcnt vmcnt(0)" ::: "memory");
    __syncthreads();
    if (threadIdx.x == 0) {
        unsigned* bar = b.bar;
        __builtin_amdgcn_s_waitcnt(0);
        unsigned nloc = b.st[0], nx = b.st[1];
        if (nloc == 0u) { xcd_barrier_complete(bar, b.x, nloc, nx); b.st[0] = nloc; b.st[1] = nx; }
        const unsigned old = xb_add(&bar[XB_XSUB(b.x)], 1u);
        const unsigned gen = old / nloc;
        if (old + 1u == (gen + 1u) * nloc) {
            __builtin_amdgcn_fence(__ATOMIC_RELEASE, "agent");
            asm volatile("s_waitcnt vmcnt(0)" ::: "memory");
            const unsigned og = xb_add(&bar[XB_TOP], 1u);
            const unsigned tg = og / nx;
            if (og + 1u == (tg + 1u) * nx) xb_add(&bar[XB_TOPGEN], 1u);
            else XB_SPIN(xb_ld(&bar[XB_TOPGEN]) == tg, bar);
            __builtin_amdgcn_fence(__ATOMIC_ACQUIRE, "agent");
            xb_add(&bar[XB_XGEN(b.x)], 1u);
            asm volatile("s_waitcnt vmcnt(0)" ::: "memory");
        } else {
            XB_SPIN(xb_ld(&bar[XB_XGEN(b.x)]) == gen, bar);
            __builtin_amdgcn_fence(__ATOMIC_ACQUIRE, "agent");
            asm volatile("s_waitcnt vmcnt(0)" ::: "memory");
        }
    }
    __syncthreads();
}

struct Args {
    const float* x; const float* norm1_g; const float* w_in; const float* lb_logits; const float* hgrn_g; const float* attn_g; const float* w_out;
    const float* norm2_g; const float* router_w; const float* router_b; const float* w_up; const float* b_up; const float* w_down; const float* b_down; const float* final_g;
    float* out; unsigned char* ws; int ph_lo, ph_hi, li, pad;
};

struct Frame { LAS unsigned char* lds; int tid, lane, wave, G, bid; };

__device__ __forceinline__ void p0_transpose_item(const float* W, int K, int N, bf16* WT, LAS float* scr, int item, int lane) {
    const int nblk = N / 32, kb = item / nblk, nb = item % nblk, k0 = 64 * kb, n0 = 32 * nb;
#pragma unroll 8
    for (int i = 0; i < 32; ++i) { const int kk = 2 * i + (lane >> 5); scr[kk * 33 + (lane & 31)] = W[(size_t)(k0 + kk) * N + n0 + (lane & 31)]; }
    asm volatile("s_waitcnt lgkmcnt(0)" ::: "memory");
    const int c = lane & 7;
#pragma unroll
    for (int j = 0; j < 4; ++j) { const int n = (lane >> 3) + 8 * j; const LAS float* s = scr + (8 * c) * 33 + n;
        v4u o; o.x = pk2(s[0 * 33], s[1 * 33]); o.y = pk2(s[2 * 33], s[3 * 33]); o.z = pk2(s[4 * 33], s[5 * 33]); o.w = pk2(s[6 * 33], s[7 * 33]);
        *(v4u*)(WT + (size_t)(n0 + n) * K + k0 + 8 * c) = o; }
    asm volatile("s_waitcnt lgkmcnt(0)" ::: "memory");
}
__device__ __forceinline__ void p0_transpose_item_fp8(const float* W, int K, int N, unsigned char* WT, LAS float* scr, int item, int lane, float sc) {
    const int nblk = N / 32, kb = item / nblk, nb = item % nblk, k0 = 64 * kb, n0 = 32 * nb;
#pragma unroll 8
    for (int i = 0; i < 32; ++i) { const int kk = 2 * i + (lane >> 5); scr[kk * 33 + (lane & 31)] = W[(size_t)(k0 + kk) * N + n0 + (lane & 31)]; }
    asm volatile("s_waitcnt lgkmcnt(0)" ::: "memory");
    const int c = lane & 7;
#pragma unroll
    for (int j = 0; j < 4; ++j) { const int n = (lane >> 3) + 8 * j; const LAS float* sp = scr + (8 * c) * 33 + n;
        v2u o; o.x = pk4_fp8(sp[0 * 33] * sc, sp[1 * 33] * sc, sp[2 * 33] * sc, sp[3 * 33] * sc); o.y = pk4_fp8(sp[4 * 33] * sc, sp[5 * 33] * sc, sp[6 * 33] * sc, sp[7 * 33] * sc);
        *(v2u*)(WT + (size_t)(n0 + n) * K + k0 + 8 * c) = o; }
    asm volatile("s_waitcnt lgkmcnt(0)" ::: "memory");
}
__device__ __forceinline__ void phase0(const Args& a, const Frame& F) {
    LAS float* scr = (LAS float*)(F.lds + F.wave * 16384);
    const int gw = F.bid * NWAVES + F.wave, NGW = F.G * NWAVES;
    constexpr int I_IN = (DM / 64) * (DPROJ / 32), I_OUT = (DM / 64) * (DM / 32), I_UP1 = (DM / 64) * (DUP / 32), I_DN1 = (DEXP / 64) * (DM / 32);
    constexpr int NITEMS = I_IN + I_OUT + NE * I_UP1 + NE * I_DN1;
    bf16* win = (bf16*)(a.ws + WS_WIN); bf16* wout = (bf16*)(a.ws + WS_WOUT); bf16* wup = (bf16*)(a.ws + WS_WUP); bf16* wdn = (bf16*)(a.ws + WS_WDN);
    for (int it = gw; it < NITEMS; it += NGW) {
        int r = it;
        if (r < I_IN) { p0_transpose_item(a.w_in, DM, DPROJ, win, scr, r, F.lane); continue; } r -= I_IN;
        if (r < I_OUT) { p0_transpose_item(a.w_out, DM, DM, wout, scr, r, F.lane); continue; } r -= I_OUT;
        if (r < NE * I_UP1) { const int e = r / I_UP1;
            if (MOE_FP8) p0_transpose_item_fp8(a.w_up + (size_t)e * DM * DUP, DM, DUP, (unsigned char*)wup + (size_t)e * DUP * DM, scr, r % I_UP1, F.lane, FP8_WSCALE);
            else p0_transpose_item(a.w_up + (size_t)e * DM * DUP, DM, DUP, wup + (size_t)e * DUP * DM, scr, r % I_UP1, F.lane); continue; } r -= NE * I_UP1;
        { const int e = r / I_DN1;
            if (MOE_FP8) p0_transpose_item_fp8(a.w_down + (size_t)e * DEXP * DM, DEXP, DM, (unsigned char*)wdn + (size_t)e * DM * DEXP, scr, r % I_DN1, F.lane, FP8_WSCALE);
            else p0_transpose_item(a.w_down + (size_t)e * DEXP * DM, DEXP, DM, wdn + (size_t)e * DM * DEXP, scr, r % I_DN1, F.lane); }
    }
    { float* bu = (float*)(a.ws + WS_BUP); float* bd = (float*)(a.ws + WS_BDN); const int gt = F.bid * NTHR + F.tid, ngt = F.G * NTHR;
      for (int i = gt; i < NE * DUP; i += ngt) bu[i] = a.b_up[i];
      for (int i = gt; i < NE * DM; i += ngt) bd[i] = a.b_down[i]; }
    bf16* xn = (bf16*)(a.ws + WS_XN);
    for (int m = gw; m < NT; m += NGW) {
        const f32x4* xr = (const f32x4*)(a.x + (size_t)m * DM) + F.lane;
        const f32x4* gr = (const f32x4*)a.norm1_g + F.lane;
        f32x4 v[4]; float s = 0.f;
#pragma unroll
        for (int j = 0; j < 4; ++j) { v[j] = xr[64 * j]; s += (v[j].x * v[j].x + v[j].y * v[j].y) + (v[j].z * v[j].z + v[j].w * v[j].w); }
        const float r = 1.0f / sqrtf(wave_sum(s) * (1.f / DM) + EPS);
        v2u* o8 = (v2u*)(xn + (size_t)m * DM) + F.lane;
#pragma unroll
        for (int j = 0; j < 4; ++j) { const f32x4 g = gr[64 * j]; v2u w; w.x = pk2(v[j].x * r * g.x, v[j].y * r * g.y); w.y = pk2(v[j].z * r * g.z, v[j].w * r * g.w); o8[64 * j] = w; }
    }
}

template <class RowPtr, class Epi>
__device__ __forceinline__ void gemm_unit_simple(const RowPtr& rp, const bf16* Bt, int K, const Epi& epi, int wave, int lane) {
    const int fr = lane & 15, fq = lane >> 4, wm = wave & 3, wn = wave >> 2;
    const bf16* ap[4]; const bf16* bp[4];
#pragma unroll
    for (int i = 0; i < 4; ++i) { ap[i] = rp(wm * 64 + i * 16 + fr) + fq * 8; bp[i] = Bt + (size_t)(wn * 64 + i * 16 + fr) * K + fq * 8; }
    f32x4 acc[4][4];
#pragma unroll
    for (int i = 0; i < 4; ++i)
#pragma unroll
        for (int j = 0; j < 4; ++j) acc[i][j] = (f32x4){0.f, 0.f, 0.f, 0.f};
    for (int k0 = 0; k0 < K; k0 += 32) {
        bf16x8 af[4], bfr[4];
#pragma unroll
        for (int i = 0; i < 4; ++i) { af[i] = *(const bf16x8*)(ap[i] + k0); bfr[i] = *(const bf16x8*)(bp[i] + k0); }
#pragma unroll
        for (int i = 0; i < 4; ++i)
#pragma unroll
            for (int j = 0; j < 4; ++j) acc[i][j] = __builtin_amdgcn_mfma_f32_16x16x32_bf16(bfr[j], af[i], acc[i][j], 0, 0, 0);
    }
#pragma unroll
    for (int i = 0; i < 4; ++i)
#pragma unroll
        for (int j = 0; j < 4; ++j) epi(wm * 64 + i * 16 + fr, wn * 64 + j * 16 + fq * 4, acc[i][j]);
}

namespace pg8 {
constexpr int BM = 256, BK = 64, HALF = 128, HTB = HALF * BK * 2, STAGE_BYTES = 8 * HTB, NXCD = 8, WGM = 8;
constexpr int TILE_E_LDS = 131072 + 256, BIAS_LDS = 132096;
__device__ __forceinline__ int lds_byte(int r, int c) { const int st = (r >> 4) * 2 + (c >> 5), rr = r & 15, cc = c & 31, ob = rr * 64 + cc * 2; return st * 1024 + (ob ^ (((ob >> 9) & 1) << 5)); }
__device__ __forceinline__ void stage_rc(int b, int& R, int& C) { const int st = b / 1024, sb = b % 1024, swz = sb ^ (((sb >> 9) & 1) << 5); R = (st >> 1) * 16 + swz / 64; C = (st & 1) * 32 + (swz % 64) / 2; }
__device__ __forceinline__ int perm32(int rho) { const int n = rho >> 4, i = rho & 15; return 8 * (i >> 2) + 4 * n + (i & 3); }
struct Unit { int pm, pn; };
__device__ __forceinline__ bool order_next(int nM, int nN, int G, int c, int i, Unit& u) {
    const int nwg = nM * nN; const long L = (long)i * G + c; if (L >= nwg) return false;
    int wgid = (int)L; { const int q = nwg / NXCD, r = nwg % NXCD, xcd = wgid % NXCD, off = wgid / NXCD; wgid = (xcd < r ? xcd * (q + 1) : r * (q + 1) + (xcd - r) * q) + off; }
    const int nig = WGM * nN, gid = wgid / nig, fm = gid * WGM, gsz = (nM - fm) < WGM ? (nM - fm) : WGM;
    u.pm = fm + ((wgid % nig) % gsz); u.pn = (wgid % nig) / gsz; return true;
}
__device__ __forceinline__ unsigned cvt_pk_bf16(float lo, float hi) { unsigned r; asm volatile("v_cvt_pk_bf16_f32 %0, %1, %2" : "=v"(r) : "v"(lo), "v"(hi)); return r; }

template <class Epi, class Sched, bool ALIGN_EPI, bool FP8 = false>
__device__ __forceinline__ void gemm_phase(LAS unsigned char* lds, const int KB, const Sched& S, const Epi& E, const unsigned char* wsb, const bool skip_epi = false) {
    const __amdgpu_buffer_rsrc_t rs = __builtin_amdgcn_make_buffer_rsrc((void*)wsb, 0, -1, 0x00020000);
    const int tid = threadIdx.x, wid = __builtin_amdgcn_readfirstlane(tid >> 6), lane = tid & 63, wr = wid >> 2, wc = wid & 3, fr = lane & 15, fq = lane >> 4;
    const int nt = KB / (BK * 2);
    unsigned voffB[2];
#pragma unroll
    for (int i = 0; i < 2; ++i) { int R, C; stage_rc(tid * 16 + i * 8192, R, C); const int Rb = Epi::BMAP == 3 ? (64 * (R >> 5) + (R & 31)) : (64 * (R >> 5) + 16 * ((R & 15) >> 2) + 4 * ((R >> 4) & 1) + (R & 3)); voffB[i] = (unsigned)(Rb * KB + C * 2); }
#define PG8_RC(Rr, Cc) int Rr[2], Cc[2]; { int tl_ = tid; asm volatile("" : "+v"(tl_)); _Pragma("unroll") for (int i_ = 0; i_ < 2; ++i_) stage_rc(tl_ * 16 + i_ * 8192, Rr[i_], Cc[i_]); }
    const unsigned kstep = (unsigned)(BK * 2);
    const unsigned hstep = (unsigned)HALF * (unsigned)KB;
    const unsigned bh = (Epi::BMAP == 3 ? 32u : 8u) * (unsigned)KB;
    const unsigned ldsw = (unsigned)wid * 1024u;
    const int aoff = lds_byte(wr * 64 + fr, fq * 8), boff = lds_byte(wc * 32 + fr, fq * 8);
#define PG8_SA(b, h) (((b) * 2 + (h)) * HTB)
#define PG8_SB(b, h) ((4 + (b) * 2 + (h)) * HTB)
#define PG8_STAGE(bufoff, gbase, v0, v1) do { \
        __builtin_amdgcn_raw_ptr_buffer_load_lds(rs, (LAS void*)(lds + (bufoff) + ldsw), 16, (int)(v0), (int)(gbase), 0, 0); \
        __builtin_amdgcn_raw_ptr_buffer_load_lds(rs, (LAS void*)(lds + (bufoff) + ldsw + 8192), 16, (int)(v1), (int)(gbase), 0, 0); } while (0)
#define PG8_STAGEB(bufoff, gbase) PG8_STAGE(bufoff, gbase, voffB[0], voffB[1])
#define PG8_LDA(dst, b, h) do { _Pragma("unroll") for (int m = 0; m < 4; ++m) _Pragma("unroll") for (int k = 0; k < 2; ++k) dst[m][k] = *(const LAS bf16x8*)(lds + PG8_SA(b, h) + aoff + m * 2048 + k * 1024); } while (0)
#define PG8_LDB(dst, b, h) do { _Pragma("unroll") for (int n = 0; n < 2; ++n) _Pragma("unroll") for (int k = 0; k < 2; ++k) dst[n][k] = *(const LAS bf16x8*)(lds + PG8_SB(b, h) + boff + n * 2048 + k * 1024); } while (0)
#define PG8_CAT(x) __builtin_shufflevector(__builtin_bit_cast(v4i, (x)[0]), __builtin_bit_cast(v4i, (x)[1]), 0, 1, 2, 3, 4, 5, 6, 7)
#define PG8_MMA(ai, bj, At, Bt) do { __builtin_amdgcn_s_setprio(1); \
        if constexpr (FP8) { _Pragma("unroll") for (int m = 0; m < 4; ++m) _Pragma("unroll") for (int n = 0; n < 2; ++n) \
            acc[ai][bj][m][n] = __builtin_amdgcn_mfma_scale_f32_16x16x128_f8f6f4(PG8_CAT(Bt[n]), PG8_CAT(At[m]), acc[ai][bj][m][n], 0, 0, 0, 0x7f7f7f7f, 0, 0x7f7f7f7f); } \
        else { _Pragma("unroll") for (int m = 0; m < 4; ++m) _Pragma("unroll") for (int n = 0; n < 2; ++n) _Pragma("unroll") for (int k = 0; k < 2; ++k) \
            acc[ai][bj][m][n] = __builtin_amdgcn_mfma_f32_16x16x32_bf16(Bt[n][k], At[m][k], acc[ai][bj][m][n], 0, 0, 0); } __builtin_amdgcn_s_setprio(0); } while (0)
#define PG8_WAIT_V(n) asm volatile("s_waitcnt vmcnt(" #n ")" ::: "memory")
#define PG8_WAIT_L(n) asm volatile("s_waitcnt lgkmcnt(" #n ")" ::: "memory")
#define PG8_BAR __builtin_amdgcn_s_barrier()
#define PG8_SCHED __builtin_amdgcn_sched_barrier(0)
    Unit cur, nxt; int ui = 0;
    if (!S.next(0, cur)) return;
    unsigned vA[2][2], vN[2][2];
    { PG8_RC(Rr, Cc) S.offsets(cur, Rr, Cc, vA); }
    bool has_next = S.next(1, nxt);
    if (Sched::GATHER) { if (has_next) { PG8_RC(Rr, Cc) S.offsets(nxt, Rr, Cc, vN); } else { vN[0][0] = vA[0][0]; vN[0][1] = vA[0][1]; vN[1][0] = vA[1][0]; vN[1][1] = vA[1][1]; } }
    f32x4 acc[2][2][4][2];
#pragma unroll
    for (int a = 0; a < 2; ++a)
#pragma unroll
        for (int b = 0; b < 2; ++b)
#pragma unroll
            for (int m = 0; m < 4; ++m)
#pragma unroll
                for (int n = 0; n < 2; ++n) acc[a][b][m][n] = (f32x4){0.f, 0.f, 0.f, 0.f};
    bf16x8 At[4][2], B0[2][2], B1[2][2];
    unsigned cA = (unsigned)(S.a_base(cur) - (const char*)wsb), cB = (unsigned)(S.b_base(cur) - (const char*)wsb);
#define PG8_BIAS(u_, slot_) do { if (Epi::LDS_BIAS && wid == 0) __builtin_amdgcn_raw_ptr_buffer_load_lds(rs, (LAS void*)(lds + BIAS_LDS + (slot_) * 1024), 16, (int)((threadIdx.x & 63) * 16), (int)E.bias_off(u_), 0, 0); } while (0)
    PG8_BIAS(cur, 0);
    PG8_STAGEB(PG8_SB(0, 0), cB); PG8_STAGEB(PG8_SB(0, 1), cB + bh); PG8_STAGE(PG8_SA(0, 0), cA, vA[0][0], vA[0][1]); PG8_STAGE(PG8_SA(0, 1), cA, vA[1][0], vA[1][1]);
    if (wr == 1) PG8_BAR;
    PG8_WAIT_V(2); PG8_BAR;
    PG8_STAGEB(PG8_SB(1, 0), cB + kstep); PG8_STAGE(PG8_SA(1, 0), cA + kstep, vA[0][0], vA[0][1]); PG8_STAGEB(PG8_SB(1, 1), cB + bh + kstep);
    PG8_WAIT_V(6); PG8_BAR;
    for (;;) {
        const unsigned nA = has_next ? (unsigned)(S.a_base(nxt) - (const char*)wsb) : cA, nB = has_next ? (unsigned)(S.b_base(nxt) - (const char*)wsb) : cB;
#pragma unroll 1
        for (int t = 0; t < nt; t += 2) {
            const bool last = (t == nt - 2);
            if constexpr (FP8) { asm volatile("" : "+v"(vA[0][0]), "+v"(vA[0][1]), "+v"(vA[1][0]), "+v"(vA[1][1]), "+v"(voffB[0]), "+v"(voffB[1])); }
            const unsigned a1 = cA + (unsigned)(t + 1) * kstep;
            const unsigned a2 = last ? nA : cA + (unsigned)(t + 2) * kstep, b2 = last ? nB : cB + (unsigned)(t + 2) * kstep;
            const unsigned a3 = a2 + kstep, b3 = b2 + kstep;
            unsigned w00, w01, w10, w11;
            if (Sched::GATHER) { const bool sw = last && has_next; w00 = sw ? vN[0][0] : vA[0][0]; w01 = sw ? vN[0][1] : vA[0][1]; w10 = sw ? vN[1][0] : vA[1][0]; w11 = sw ? vN[1][1] : vA[1][1]; }
            else { w00 = vA[0][0]; w01 = vA[0][1]; w10 = vA[1][0]; w11 = vA[1][1]; }
            PG8_LDB(B0, 0, 0); PG8_LDB(B1, 0, 1); PG8_SCHED; PG8_LDA(At, 0, 0); PG8_STAGE(PG8_SA(1, 1), a1, vA[1][0], vA[1][1]);
            PG8_WAIT_V(8); PG8_WAIT_L(0); PG8_BAR; PG8_MMA(0, 0, At, B0); PG8_MMA(0, 1, At, B1); PG8_BAR; PG8_SCHED;
            PG8_LDA(At, 0, 1); PG8_STAGEB(PG8_SB(0, 0), b2); PG8_STAGEB(PG8_SB(0, 1), b2 + bh); PG8_STAGE(PG8_SA(0, 0), a2, w00, w01);
            PG8_WAIT_V(8); PG8_WAIT_L(0); PG8_BAR; PG8_MMA(1, 0, At, B0); PG8_MMA(1, 1, At, B1); PG8_BAR; PG8_SCHED;
            PG8_LDB(B0, 1, 0); PG8_LDB(B1, 1, 1); PG8_SCHED; PG8_LDA(At, 1, 0); PG8_STAGE(PG8_SA(0, 1), a2, w10, w11);
            PG8_WAIT_V(8); PG8_WAIT_L(0); PG8_BAR; PG8_MMA(0, 0, At, B0); PG8_MMA(0, 1, At, B1); PG8_BAR; PG8_SCHED;
            PG8_LDA(At, 1, 1); PG8_STAGEB(PG8_SB(1, 0), b3); PG8_STAGEB(PG8_SB(1, 1), b3 + bh); PG8_STAGE(PG8_SA(1, 0), a3, w00, w01);
            PG8_WAIT_V(8); PG8_WAIT_L(0); PG8_BAR; PG8_MMA(1, 0, At, B0); PG8_MMA(1, 1, At, B1); PG8_BAR; PG8_SCHED;
        }
        if constexpr (ALIGN_EPI) { if (wr == 0) PG8_BAR; }
        unsigned vT[2][2];
        Unit n2; bool has_n2 = false;
        if (Sched::GATHER) { has_n2 = has_next && S.next(ui + 2, n2); if (has_n2) { PG8_RC(Rr, Cc) S.tokens(n2, Rr, vT); } }
        { int l2 = threadIdx.x & 63; asm volatile("" : "+v"(l2));
          if (!((PROBE_SKIP & 32) && skip_epi)) E(acc, cur, wr, wc, l2 & 15, l2 >> 4, (const LAS float*)(lds + BIAS_LDS + (ui & 1) * 1024)); }
        if (!has_next) break;
#pragma unroll
        for (int a = 0; a < 2; ++a)
#pragma unroll
            for (int b = 0; b < 2; ++b)
#pragma unroll
                for (int m = 0; m < 4; ++m)
#pragma unroll
                    for (int n = 0; n < 2; ++n) acc[a][b][m][n] = (f32x4){0.f, 0.f, 0.f, 0.f};
        cur = nxt; cA = nA; cB = nB; ++ui;
        PG8_BIAS(cur, ui & 1);
        if (Sched::GATHER) { PG8_RC(Rr, Cc)
#pragma unroll
            for (int h = 0; h < 2; ++h)
#pragma unroll
                for (int i = 0; i < 2; ++i) { vA[h][i] = vN[h][i]; if (has_n2) vN[h][i] = vT[h][i] * (unsigned)KB + (unsigned)Cc[i] * 2u; }
            has_next = has_n2; nxt = n2;
        } else has_next = S.next(ui + 1, nxt);
        if constexpr (ALIGN_EPI) { if (wr == 1) PG8_BAR; }
    }
    PG8_WAIT_V(0);
    if constexpr (!ALIGN_EPI) { if (wr == 0) PG8_BAR; }
    PG8_BAR;
#undef PG8_SA
#undef PG8_SB
#undef PG8_STAGE
#undef PG8_STAGEB
#undef PG8_LDA
#undef PG8_LDB
#undef PG8_MMA
#undef PG8_BIAS
#undef PG8_RC
#undef PG8_CAT
#undef PG8_WAIT_V
#undef PG8_WAIT_L
#undef PG8_BAR
#undef PG8_SCHED
}

struct DenseSched {
    static constexpr bool GATHER = false;
    const bf16* A; const bf16* Bt; int nM, nN, G, c, KB;
    __device__ __forceinline__ bool next(int i, Unit& u) const { return order_next(nM, nN, G, c, i, u); }
    __device__ __forceinline__ const char* a_base(const Unit& u) const { return (const char*)A + (size_t)u.pm * BM * KB; }
    __device__ __forceinline__ const char* b_base(const Unit& u) const { return (const char*)Bt + (size_t)u.pn * BM * KB; }
    __device__ __forceinline__ void offsets(const Unit&, const int (&R)[2], const int (&C)[2], unsigned (&v)[2][2]) const {
#pragma unroll
        for (int h = 0; h < 2; ++h)
#pragma unroll
            for (int i = 0; i < 2; ++i) v[h][i] = (unsigned)((h * HALF + R[i]) * KB + C[i] * 2); }
    __device__ __forceinline__ void tokens(const Unit&, const int (&)[2], unsigned (&)[2][2]) const {}
};
template <bool GATHER_>
struct MoeSched {
    static constexpr bool GATHER = GATHER_;
    const void* A; const void* W; const int* rowtok; const LAS int* tstart; int TM, nN, G, c, KB; size_t wstride;
    __device__ __forceinline__ int expert(int pm) const { return __builtin_amdgcn_readfirstlane((int)((const LAS unsigned char*)((const LAS unsigned char*)tstart + 256))[pm]); }
    __device__ __forceinline__ bool next(int i, Unit& u) const { return order_next(TM, nN, G, c, i, u); }
    __device__ __forceinline__ const char* a_base(const Unit& u) const { return GATHER ? (const char*)A : (const char*)A + (size_t)u.pm * BM * KB; }
    __device__ __forceinline__ const char* b_base(const Unit& u) const { return (const char*)W + (size_t)expert(u.pm) * wstride + (size_t)u.pn * BM * KB; }
    __device__ __forceinline__ void tokens(const Unit& u, const int (&R)[2], unsigned (&v)[2][2]) const {
#pragma unroll
        for (int h = 0; h < 2; ++h)
#pragma unroll
            for (int i = 0; i < 2; ++i) v[h][i] = (unsigned)rowtok[(size_t)u.pm * BM + h * HALF + R[i]]; }
    __device__ __forceinline__ void offsets(const Unit& u, const int (&R)[2], const int (&C)[2], unsigned (&v)[2][2]) const {
        if (GATHER) { tokens(u, R, v);
#pragma unroll
            for (int h = 0; h < 2; ++h)
#pragma unroll
                for (int i = 0; i < 2; ++i) v[h][i] = v[h][i] * (unsigned)KB + (unsigned)C[i] * 2u; }
        else {
#pragma unroll
            for (int h = 0; h < 2; ++h)
#pragma unroll
                for (int i = 0; i < 2; ++i) v[h][i] = (unsigned)((h * HALF + R[i]) * KB + C[i] * 2); } }
};

struct EpiProj {
    static constexpr bool PERM = true, LDS_BIAS = false; static constexpr int BMAP = 2;
    bf16* O; bf16* KV; bf16* QH;
    __device__ __forceinline__ unsigned bias_off(const Unit&) const { return 0u; }
    __device__ __forceinline__ void operator()(const f32x4 (&acc)[2][2][4][2], const Unit& u, int wr, int wc, int fr, int fq, const LAS float*) const {
        const float sc = (u.pn == 8 || u.pn == 9) ? 0.125f : 1.0f;
        const int row0 = u.pm * BM + wr * 64 + fr, col0 = u.pn * BM + wc * 64 + 16 * fq;
        if (u.pn >= 8 && u.pn < 10) {
            const int ck = col0 - C_AQ;
#pragma unroll
            for (int ai = 0; ai < 2; ++ai)
#pragma unroll
                for (int m = 0; m < 4; ++m) { const int row = row0 + ai * HALF + m * 16; const int bb = row >> 12, t = row & (SEQ - 1);
#pragma unroll
                    for (int bj = 0; bj < 2; ++bj) { const int cc = ck + bj * 8; const f32x4 v0 = acc[ai][bj][m][0] * 0.125f, v1 = acc[ai][bj][m][1] * 0.125f;
                        v4u w; w.x = cvt_pk_bf16(v0[0], v0[1]); w.y = cvt_pk_bf16(v0[2], v0[3]); w.z = cvt_pk_bf16(v1[0], v1[1]); w.w = cvt_pk_bf16(v1[2], v1[3]);
                        *(v4u*)(QH + ((size_t)(bb * 8 + (cc >> 6)) * SEQ + t) * 64 + (cc & 63)) = w; } }
            return;
        }
        if (u.pn >= 10) {
            const int isv = u.pn >= 12; const int ck = col0 - (isv ? C_AV : C_AK);
#pragma unroll
            for (int ai = 0; ai < 2; ++ai)
#pragma unroll
                for (int m = 0; m < 4; ++m) { const int row = row0 + ai * HALF + m * 16; const int bb = row >> 12, t = row & (SEQ - 1);
#pragma unroll
                    for (int bj = 0; bj < 2; ++bj) { const int cc = ck + bj * 8; const f32x4 v0 = acc[ai][bj][m][0], v1 = acc[ai][bj][m][1];
                        v4u w; w.x = cvt_pk_bf16(v0[0], v0[1]); w.y = cvt_pk_bf16(v0[2], v0[3]); w.z = cvt_pk_bf16(v1[0], v1[1]); w.w = cvt_pk_bf16(v1[2], v1[3]);
                        *(v4u*)(KV + ((size_t)(bb * 8 + (cc >> 6)) * SEQ + t) * 128 + isv * 64 + (cc & 63)) = w; } }
            return;
        }
#pragma unroll
        for (int ai = 0; ai < 2; ++ai)
#pragma unroll
            for (int m = 0; m < 4; ++m) { bf16* rowp = O + (size_t)(row0 + ai * HALF + m * 16) * DPROJ + col0;
#pragma unroll
                for (int bj = 0; bj < 2; ++bj) { const f32x4 v0 = acc[ai][bj][m][0] * sc, v1 = acc[ai][bj][m][1] * sc;
                    v4u w; w.x = cvt_pk_bf16(v0[0], v0[1]); w.y = cvt_pk_bf16(v0[2], v0[3]); w.z = cvt_pk_bf16(v1[0], v1[1]); w.w = cvt_pk_bf16(v1[2], v1[3]);
                    *(v4u*)(rowp + bj * 8) = w; } }
    }
};
struct EpiRes {
    static constexpr bool PERM = true, LDS_BIAS = false; static constexpr int BMAP = 3;
    const float* X; float* O;
    __device__ __forceinline__ unsigned bias_off(const Unit&) const { return 0u; }
    __device__ __forceinline__ void operator()(const f32x4 (&acc)[2][2][4][2], const Unit& u, int wr, int wc, int fr, int fq, const LAS float*) const {
        const int col0 = u.pn * BM + wc * 64 + 4 * fq;
#pragma unroll
        for (int ai = 0; ai < 2; ++ai)
#pragma unroll
            for (int m = 0; m < 4; ++m) { const size_t off = (size_t)(u.pm * BM + ai * HALF + wr * 64 + m * 16 + fr) * DM + col0;
#pragma unroll
                for (int bj = 0; bj < 2; ++bj)
#pragma unroll
                    for (int n = 0; n < 2; ++n) { const f32x4 xv = *(const f32x4*)(X + off + bj * 32 + n * 16); *(f32x4*)(O + off + bj * 32 + n * 16) = xv + acc[ai][bj][m][n]; }
                if (m & 1) asm volatile("" ::: "memory"); }
    }
};
struct EpiSwiglu {
    static constexpr bool PERM = true, LDS_BIAS = true; static constexpr int BMAP = 2;
    bf16* O; const float* bias; const LAS unsigned char* tile_e;
    __device__ __forceinline__ unsigned bias_off(const Unit& u) const { return (unsigned)(WS_BUP + ((size_t)tile_e[u.pm] * DUP + (size_t)u.pn * BM) * 4); }
    __device__ __forceinline__ void operator()(const f32x4 (&acc)[2][2][4][2], const Unit& u, int wr, int wc, int fr, int fq, const LAS float* bl) const {
        const int row0 = u.pm * BM + wr * 64 + fr, col0 = u.pn * BM + wc * 64 + 16 * fq;
        const LAS float* bp = bl + wc * 64 + 16 * fq;
#pragma unroll
        for (int bj = 0; bj < 2; ++bj) {
        const f32x4 bv0 = *(const LAS f32x4*)(bp + bj * 8), bv1 = *(const LAS f32x4*)(bp + bj * 8 + 4);
#pragma unroll
        for (int ai = 0; ai < 2; ++ai)
#pragma unroll
            for (int m = 0; m < 4; ++m) { bf16* rowp = O + (size_t)(row0 + ai * HALF + m * 16) * DEXP + (col0 >> 1);
                unsigned char* rowp8 = (unsigned char*)O + (size_t)(row0 + ai * HALF + m * 16) * DEXP + (col0 >> 1);
                { const float ws = MOE_FP8 ? FP8_WINV : 1.0f; const f32x4 v0 = acc[ai][bj][m][0] * ws + bv0, v1 = acc[ai][bj][m][1] * ws + bv1;
                    float r[4];
#pragma unroll
                    for (int p = 0; p < 4; ++p) { const float gl = fminf(p < 2 ? v0[2 * p] : v1[2 * p - 4], 7.0f); const float li = fminf(fmaxf(p < 2 ? v0[2 * p + 1] : v1[2 * p - 3], -7.0f), 7.0f);
                        r[p] = gl * __builtin_amdgcn_rcpf(1.0f + __builtin_amdgcn_exp2f(-1.702f * 1.4426950408889634f * gl)) * (li + 1.0f); }
                    if (MOE_FP8) *(unsigned*)(rowp8 + bj * 4) = pk4_fp8(r[0], r[1], r[2], r[3]);
                    else { v2u w; w.x = cvt_pk_bf16(r[0], r[1]); w.y = cvt_pk_bf16(r[2], r[3]); *(v2u*)(rowp + bj * 4) = w; } } }
        }
    }
};
struct EpiY {
    static constexpr bool PERM = true, LDS_BIAS = true; static constexpr int BMAP = 2;
    bf16* O; const float* bias; const LAS unsigned char* tile_e;
    __device__ __forceinline__ unsigned bias_off(const Unit& u) const { return (unsigned)(WS_BDN + ((size_t)tile_e[u.pm] * DM + (size_t)u.pn * BM) * 4); }
    __device__ __forceinline__ void operator()(const f32x4 (&acc)[2][2][4][2], const Unit& u, int wr, int wc, int fr, int fq, const LAS float* bl) const {
        const int row0 = u.pm * BM + wr * 64 + fr, col0 = u.pn * BM + wc * 64 + 16 * fq;
        const LAS float* bp = bl + wc * 64 + 16 * fq;
        f32x4 bv[2][2];
#pragma unroll
        for (int bj = 0; bj < 2; ++bj)
#pragma unroll
            for (int n = 0; n < 2; ++n) bv[bj][n] = *(const LAS f32x4*)(bp + bj * 8 + 4 * n);
#pragma unroll
        for (int ai = 0; ai < 2; ++ai)
#pragma unroll
            for (int m = 0; m < 4; ++m) { bf16* rowp = O + (size_t)(row0 + ai * HALF + m * 16) * DM + col0;
#pragma unroll
                for (int bj = 0; bj < 2; ++bj) { const float ws = MOE_FP8 ? FP8_WINV : 1.0f; const f32x4 v0 = acc[ai][bj][m][0] * ws + bv[bj][0], v1 = acc[ai][bj][m][1] * ws + bv[bj][1];
                    v4u w; w.x = cvt_pk_bf16(v0[0], v0[1]); w.y = cvt_pk_bf16(v0[2], v0[3]); w.z = cvt_pk_bf16(v1[0], v1[1]); w.w = cvt_pk_bf16(v1[2], v1[3]);
                    *(v4u*)(rowp + bj * 8) = w; } }
    }
};
}

#ifndef FAST_GEMM
#define FAST_GEMM 1
#endif
__device__ __forceinline__ void phase1(const Args& a, const Frame& F) {
    const bf16* xn = (const bf16*)(a.ws + WS_XN); const bf16* win = (const bf16*)(a.ws + WS_WIN); bf16* proj = (bf16*)(a.ws + WS_PROJ);
#if FAST_GEMM
    { pg8::DenseSched S{xn, win, NT / 256, DPROJ / 256, F.G, F.bid, DM * 2}; pg8::EpiProj E{proj, (bf16*)(a.ws + WS_KV), (bf16*)(a.ws + WS_QH)}; pg8::gemm_phase<pg8::EpiProj, pg8::DenseSched, true>(F.lds, DM * 2, S, E, a.ws, a.li == 1); return; }
#endif
    constexpr int NPN = DPROJ / 128, NU = (NT / 256) * NPN;
    for (int u = F.bid; u < NU; u += F.G) {
        const int pm = u / NPN, pn = u % NPN;
        const bf16* A0 = xn + (size_t)pm * 256 * DM;
        auto rp = [&](int r) { return A0 + (size_t)r * DM; };
        bf16* O = proj + (size_t)pm * 256 * DPROJ + pn * 128;
        const float sc = (pn * 128 >= C_AQ && pn * 128 < C_AK) ? 0.125f : 1.0f;
        auto epi = [&](int r, int c, const f32x4& v) { v2u w; w.x = pk2(v.x * sc, v.y * sc); w.y = pk2(v.z * sc, v.w * sc); *(v2u*)(O + (size_t)r * DPROJ + c) = w; };
        gemm_unit_simple(rp, win + (size_t)pn * 128 * DM, DM, epi, F.wave, F.lane);
    }
}

__device__ __forceinline__ void hgrn_simple(const Args& a, const Frame& F, int item) {
    const int b = item >> 2, h = item & 3;
    const bf16* proj = (const bf16*)(a.ws + WS_PROJ); bf16* mix = (bf16*)(a.ws + WS_MIX);
    LAS float* stage = (LAS float*)F.lds;
    LAS float* spart = (LAS float*)(F.lds + 32768);
    LAS float* wsum = (LAS float*)(F.lds + 32768 + 2048);
    const int tid = F.tid, v = tid & 127, kq = tid >> 7;
    float S[32];
#pragma unroll
    for (int i = 0; i < 32; ++i) S[i] = 0.f;
    const int scol = (kq == 0 ? C_HQ : kq == 1 ? C_HF : kq == 2 ? C_HI : C_HG) + h * 128 + v;
    float lbv = 0.f;
    { const float l0 = a.lb_logits[h * 128 + v], l1 = a.lb_logits[DH + h * 128 + v]; lbv = 1.0f / (1.0f + __expf(l1 - l0)); }
    const float gn = a.hgrn_g[h * 128 + v];
    const bf16* pbase = proj + (size_t)b * SEQ * DPROJ + scol;
    float pre[8];
#pragma unroll
    for (int i = 0; i < 8; ++i) pre[i] = bf2f(pbase[(size_t)i * DPROJ]);
    for (int t0 = 0; t0 < SEQ; t0 += 8) {
        const int buf = (t0 >> 3) & 1;
        LAS float* st = stage + buf * 4096;
#pragma unroll
        for (int i = 0; i < 8; ++i) { float val = pre[i]; if (kq == 1) val = lbv + (1.0f - lbv) / (1.0f + __expf(-val)); st[i * 512 + tid] = val; }
        if (t0 + 8 < SEQ) {
#pragma unroll
            for (int i = 0; i < 8; ++i) pre[i] = bf2f(pbase[(size_t)(t0 + 8 + i) * DPROJ]);
        }
        __syncthreads();
#pragma unroll 1
        for (int i = 0; i < 8; ++i) {
            const LAS float* sq = st + i * 512; const LAS float* sf = sq + 128; const LAS float* sv = sq + 256; const LAS float* sg = sq + 384;
            const float vv = sv[v]; float part = 0.f;
#pragma unroll
            for (int j = 0; j < 32; ++j) { const int k = kq * 32 + j; const float f = sf[k]; S[j] = f * S[j] + (1.0f - f) * vv; part += sq[k] * S[j]; }
            spart[kq * 128 + v] = part;
            __syncthreads();
            float o = 0.f;
            if (tid < 128) { o = (spart[v] + spart[128 + v]) + (spart[256 + v] + spart[384 + v]); const float ss = wave_sum(o * o); if (F.lane == 0) wsum[F.wave] = ss; }
            __syncthreads();
            if (tid < 128) {
                const float ms = (wsum[0] + wsum[1]) * (1.0f / 128.0f); const float r = 1.0f / sqrtf(ms + EPS);
                const float g = sg[v]; const float silu = g / (1.0f + __expf(-g));
                mix[(size_t)(b * SEQ + t0 + i) * DM + h * 128 + v] = (bf16)f2bf(o * r * gn * silu);
            }
        }
    }
    __syncthreads();
}

__device__ __forceinline__ void attn_simple(const Args& a, const Frame& F, int first_wave, int n_waves) {
    const bf16* proj = (const bf16*)(a.ws + WS_PROJ); bf16* mix = (bf16*)(a.ws + WS_MIX);
    const int lane = F.lane;
    for (int item = first_wave; item < NT * 8; item += n_waves) {
        const int row = item >> 3, h = item & 7, t = row & (SEQ - 1), b = row >> 12;
        const float qd = bf2f(proj[(size_t)row * DPROJ + C_AQ + h * 64 + lane]);
        const bf16* kb = proj + (size_t)b * SEQ * DPROJ + C_AK + h * 64;
        const bf16* vb = proj + (size_t)b * SEQ * DPROJ + C_AV + h * 64;
        float m = -INFINITY, l = 0.f, o = 0.f;
#pragma unroll 1
        for (int p = 0; p < 3; ++p) {
            const int dil = (p == 0) ? 1 : (p == 1 ? 4 : 16);
            const int mq = t / dil; const int nkeys = (mq < 128 ? mq : 128) + 1;
#pragma unroll 1
            for (int j0 = 0; j0 < nkeys; j0 += 64) {
                const int j = j0 + lane; const bool valid = j < nkeys; const int kt = valid ? (t - j * dil) : t;
                const v4u* kr = (const v4u*)(kb + (size_t)kt * DPROJ);
                float s = 0.f;
#pragma unroll
                for (int c = 0; c < 8; ++c) { const v4u w = kr[c];
                    s += bflo(w.x) * RL(qd, 8 * c + 0) + bfhi(w.x) * RL(qd, 8 * c + 1) + bflo(w.y) * RL(qd, 8 * c + 2) + bfhi(w.y) * RL(qd, 8 * c + 3)
                       + bflo(w.z) * RL(qd, 8 * c + 4) + bfhi(w.z) * RL(qd, 8 * c + 5) + bflo(w.w) * RL(qd, 8 * c + 6) + bfhi(w.w) * RL(qd, 8 * c + 7); }
                s = valid ? s : -INFINITY;
                const float mn = fmaxf(m, wave_max(s));
                const float pj = valid ? __expf(s - mn) : 0.f; const float alpha = __expf(m - mn);
                l = l * alpha + wave_sum(pj); o *= alpha; m = mn;
                const int nv = (nkeys - j0) < 64 ? (nkeys - j0) : 64;
#pragma unroll 1
                for (int jj = 0; jj < nv; ++jj) { const float pv = RL(pj, jj); o += pv * bf2f(vb[(size_t)(t - (j0 + jj) * dil) * DPROJ + lane]); }
            }
        }
        o = o / l;
        const float ms = wave_sum(o * o) * (1.0f / 64.0f); const float r = 1.0f / sqrtf(ms + EPS);
        mix[(size_t)row * DM + DH + h * 64 + lane] = (bf16)f2bf(o * r * a.attn_g[h * 64 + lane]);
    }
}

typedef float f32x16 __attribute__((ext_vector_type(16)));
typedef float f32x8 __attribute__((ext_vector_type(8)));
typedef short s16x4 __attribute__((ext_vector_type(4)));
typedef __bf16 bf16x8_t __attribute__((ext_vector_type(8)));
typedef __bf16 bf16x4_t __attribute__((ext_vector_type(4)));
#define MFMA32(a, b, c) __builtin_amdgcn_mfma_f32_32x32x16_bf16((a), (b), (c), 0, 0, 0)
__device__ __forceinline__ int crow(int reg, int h) { return (reg & 3) + 8 * (reg >> 2) + 4 * h; }
#define PACK8(x, s) __builtin_bit_cast(bf16x8, __builtin_convertvector((f32x8){(x)[8 * (s)], (x)[8 * (s) + 1], (x)[8 * (s) + 2], (x)[8 * (s) + 3], (x)[8 * (s) + 4], (x)[8 * (s) + 5], (x)[8 * (s) + 6], (x)[8 * (s) + 7]}, bf16x8_t))
#define TR16(p) __builtin_amdgcn_ds_read_tr16_b64_v4i16((LAS s16x4*)(p))
constexpr int ATT_TASKS = NBATCH * 8 * 3 * 128;
constexpr int ATT_WLDS = 6144, ATT_VSTR = 192, ATT_OSTR = 144;
constexpr float LOG2E = 1.4426950408889634f, LN2 = 0.6931471805599453f;

__device__ __forceinline__ void attn_task(const bf16* proj, bf16* op, float* lse, LAS unsigned char* wl, int task, int lane) {
    const int qt = task & 127; int rr = task >> 7; const int p = rr % 3; rr /= 3; const int h = rr & 7, b = rr >> 3;
    const int dsh = 2 * p, tpc = 128 >> dsh, r = qt / tpc, m0 = (qt & (tpc - 1)) << 5;
    const int c = lane & 31, h2 = lane >> 5;
    const bf16* base = proj + (size_t)b * SEQ * DPROJ + h * 64;
    const int tq = ((m0 + c) << dsh) + r;
    bf16x8 qf[4];
    { const bf16* qp = base + (size_t)tq * DPROJ + C_AQ + 8 * h2;
#pragma unroll
      for (int s = 0; s < 4; ++s) qf[s] = *(const bf16x8*)(qp + 16 * s); }
    const int kt0 = m0 >= 128 ? 0 : ((128 - m0) >> 5);
    f32x16 st[5];
#pragma unroll
    for (int kt = 0; kt < 5; ++kt) {
#pragma unroll
        for (int i = 0; i < 16; ++i) st[kt][i] = 0.f;
        if (kt >= kt0) {
            const int tk = ((m0 - 128 + 32 * kt + c) << dsh) + r;
            const bf16* kp = base + (size_t)tk * DPROJ + C_AK + 8 * h2;
            bf16x8 kf[4];
#pragma unroll
            for (int s = 0; s < 4; ++s) kf[s] = *(const bf16x8*)(kp + 16 * s);
#pragma unroll
            for (int s = 0; s < 4; ++s) st[kt] = MFMA32(kf[s], qf[s], st[kt]);
        }
    }
    float mx = -INFINITY;
#pragma unroll
    for (int kt = 0; kt < 5; ++kt)
#pragma unroll
        for (int i = 0; i < 16; ++i) { const int kl = crow(i, h2); const bool valid = (kt >= kt0) && (kt == 0 ? kl >= c : (kt == 4 ? kl <= c : true));
            const float s = valid ? st[kt][i] : -INFINITY; st[kt][i] = s; mx = fmaxf(mx, s); }
    mx = fmaxf(mx, __shfl_xor(mx, 32));
    float l = 0.f; const float mb = mx * LOG2E;
#pragma unroll
    for (int kt = 0; kt < 5; ++kt)
#pragma unroll
        for (int i = 0; i < 16; ++i) { const float pv = __builtin_amdgcn_exp2f(st[kt][i] * LOG2E - mb); st[kt][i] = pv; l += pv; }
    l += __shfl_xor(l, 32);
    f32x16 o0, o1;
#pragma unroll
    for (int i = 0; i < 16; ++i) { o0[i] = 0.f; o1[i] = 0.f; }
    const int g4 = lane >> 4, i16 = lane & 15, q4 = i16 >> 2, p4 = i16 & 3, blk = g4 & 1;
    LAS unsigned char* trb = wl + (4 * h2 + q4) * ATT_VSTR + (16 * blk + 4 * p4) * 2;
#pragma unroll
    for (int kt = 0; kt < 5; ++kt) {
        if (kt >= kt0) {
            v4u vr[4];
#pragma unroll
            for (int i = 0; i < 4; ++i) { const int row = (lane >> 3) + 8 * i; const int tk = ((m0 - 128 + 32 * kt + row) << dsh) + r;
                vr[i] = *(const v4u*)(base + (size_t)tk * DPROJ + C_AV + 8 * (lane & 7)); }
#pragma unroll
            for (int i = 0; i < 4; ++i) *(LAS v4u*)(wl + ((lane >> 3) + 8 * i) * ATT_VSTR + (lane & 7) * 16) = vr[i];
#pragma unroll
            for (int s = 0; s < 2; ++s) {
                const bf16x8 pf = PACK8(st[kt], s);
                const s16x4 a0 = TR16(trb + (16 * s) * ATT_VSTR), a1 = TR16(trb + (16 * s + 8) * ATT_VSTR);
                const s16x4 c0 = TR16(trb + (16 * s) * ATT_VSTR + 64), c1 = TR16(trb + (16 * s + 8) * ATT_VSTR + 64);
                o0 = MFMA32(__builtin_shufflevector(a0, a1, 0, 1, 2, 3, 4, 5, 6, 7), pf, o0);
                o1 = MFMA32(__builtin_shufflevector(c0, c1, 0, 1, 2, 3, 4, 5, 6, 7), pf, o1);
            }
        }
    }
    const float inv = 1.0f / l;
#pragma unroll
    for (int g = 0; g < 4; ++g) {
        const bf16x4_t w0 = __builtin_convertvector((f32x4){o0[4 * g] * inv, o0[4 * g + 1] * inv, o0[4 * g + 2] * inv, o0[4 * g + 3] * inv}, bf16x4_t);
        const bf16x4_t w1 = __builtin_convertvector((f32x4){o1[4 * g] * inv, o1[4 * g + 1] * inv, o1[4 * g + 2] * inv, o1[4 * g + 3] * inv}, bf16x4_t);
        *(LAS v2u*)(wl + c * ATT_OSTR + (8 * g + 4 * h2) * 2) = __builtin_bit_cast(v2u, w0);
        *(LAS v2u*)(wl + c * ATT_OSTR + (32 + 8 * g + 4 * h2) * 2) = __builtin_bit_cast(v2u, w1);
    }
    bf16* ob = op + (size_t)p * NT * DH + (size_t)b * SEQ * DH + h * 64;
#pragma unroll
    for (int i = 0; i < 4; ++i) { const int row = (lane >> 3) + 8 * i; const v4u w = *(const LAS v4u*)(wl + row * ATT_OSTR + (lane & 7) * 16);
        const int tok = ((m0 + row) << dsh) + r; *(v4u*)(ob + (size_t)tok * DH + 8 * (lane & 7)) = w; }
    if (h2 == 0) lse[(size_t)p * NT * 8 + (size_t)(b * SEQ + tq) * 8 + h] = mx + __builtin_amdgcn_logf(l) * LN2;
}

constexpr int ATT_ITEMS = NBATCH * 8 * 3 * 16;
constexpr int AT_KI = 0, AT_VI = 49152, AT_WO = 98304, AT_WOB = 4608;
struct AttItem { int b, h, dsh, r, m0; };
__device__ __forceinline__ AttItem att_decode(int item) { AttItem t; const int j = item & 15; int rr = item >> 4; const int p = rr % 3; rr /= 3; t.h = rr & 7; t.b = rr >> 3; t.dsh = 2 * p; const int gpc = 16 >> t.dsh; t.r = j / gpc; t.m0 = (j % gpc) << 8; return t; }
__device__ __forceinline__ void att_load(const bf16* kvb, const AttItem& t, int tid, v4u (&kr)[12]) {
    const bf16* base = kvb + (size_t)(t.b * 8 + t.h) * SEQ * 128 + 8 * (tid & 15);
#pragma unroll
    for (int n = 0; n < 12; ++n) { const int row = (tid >> 4) + 32 * n; const int mk = t.m0 - 128 + row;
        if (mk >= 0) kr[n] = *(const v4u*)(base + (size_t)((mk << t.dsh) + t.r) * 128); }
}
__device__ __forceinline__ void att_stage(LAS unsigned char* L, int tid, const v4u (&kr)[12]) {
    const int pc = tid & 15, ch = pc & 7, isv = pc >> 3;
#pragma unroll
    for (int n = 0; n < 12; ++n) { const int row = (tid >> 4) + 32 * n;
        const int off = isv ? (AT_VI + row * 128 + 16 * (ch ^ (((row >> 1) & 1) << 2))) : (AT_KI + row * 128 + 16 * (ch ^ ((row >> 1) & 7)));
        *(LAS v4u*)(L + off) = kr[n]; }
}
__device__ __forceinline__ void att_scores(LAS unsigned char* L, const AttItem& t, const bf16x8 (&qf)[4], bf16x8 (&pfr)[5][2], float& mx_out, float& l_out, int w, int lane) {
    const int c = lane & 31, h2 = lane >> 5, m0 = t.m0 + 32 * w;
    const int kt0 = m0 >= 128 ? 0 : ((128 - m0) >> 5);
    f32x16 st[5];
#pragma unroll
    for (int kt = 0; kt < 5; ++kt) {
#pragma unroll
        for (int i = 0; i < 16; ++i) st[kt][i] = 0.f;
        if (kt >= kt0) { const int row = 32 * (w + kt) + c;
#pragma unroll
            for (int s = 0; s < 4; ++s) { const bf16x8 kf = *(const LAS bf16x8*)(L + AT_KI + row * 128 + 16 * ((2 * s + h2) ^ ((row >> 1) & 7))); st[kt] = MFMA32(kf, qf[s], st[kt]); } }
    }
    float mx = -INFINITY;
#pragma unroll
    for (int kt = 0; kt < 5; ++kt)
#pragma unroll
        for (int i = 0; i < 16; ++i) { const int kl = crow(i, h2); const bool valid = (kt >= kt0) && (kt == 0 ? kl >= c : (kt == 4 ? kl <= c : true));
            const float s = valid ? st[kt][i] : -INFINITY; st[kt][i] = s; mx = fmaxf(mx, s); }
    mx = fmaxf(mx, __shfl_xor(mx, 32));
    float l = 0.f; const float mb = mx * LOG2E;
#pragma unroll
    for (int kt = 0; kt < 5; ++kt)
#pragma unroll
        for (int i = 0; i < 16; ++i) { const float pv = __builtin_amdgcn_exp2f(st[kt][i] * LOG2E - mb); st[kt][i] = pv; l += pv; }
    l += __shfl_xor(l, 32);
#pragma unroll
    for (int kt = 0; kt < 5; ++kt) { pfr[kt][0] = PACK8(st[kt], 0); pfr[kt][1] = PACK8(st[kt], 1); }
    mx_out = mx; l_out = l;
}
__device__ __forceinline__ void att_pv(bf16* op, float* lse, LAS unsigned char* L, const AttItem& t, const bf16x8 (&pfr)[5][2], float mx, float l, int w, int lane) {
    const int c = lane & 31, h2 = lane >> 5, dsh = t.dsh, r = t.r, m0 = t.m0 + 32 * w, p = dsh >> 1;
    const int tq = ((m0 + c) << dsh) + r;
    const int kt0 = m0 >= 128 ? 0 : ((128 - m0) >> 5);
    f32x16 o0, o1;
#pragma unroll
    for (int i = 0; i < 16; ++i) { o0[i] = 0.f; o1[i] = 0.f; }
    const int g4 = lane >> 4, i16 = lane & 15, q4 = i16 >> 2, p4 = i16 & 3, blk = g4 & 1;
#pragma unroll
    for (int kt = 0; kt < 5; ++kt) {
        if (kt >= kt0) {
#pragma unroll
            for (int s = 0; s < 2; ++s) {
                const bf16x8 pf = pfr[kt][s];
                const int ra = 32 * (w + kt) + 16 * s + 4 * h2 + q4, rb = ra + 8;
                const int sa = ((ra >> 1) & 1) << 2, sb = ((rb >> 1) & 1) << 2, ch0 = 2 * blk + (p4 >> 1), hf = 8 * (p4 & 1);
                const s16x4 a0 = TR16(L + AT_VI + ra * 128 + 16 * (ch0 ^ sa) + hf), a1 = TR16(L + AT_VI + rb * 128 + 16 * (ch0 ^ sb) + hf);
                const s16x4 c0 = TR16(L + AT_VI + ra * 128 + 16 * ((4 + ch0) ^ sa) + hf), c1 = TR16(L + AT_VI + rb * 128 + 16 * ((4 + ch0) ^ sb) + hf);
                o0 = MFMA32(__builtin_shufflevector(a0, a1, 0, 1, 2, 3, 4, 5, 6, 7), pf, o0);
                o1 = MFMA32(__builtin_shufflevector(c0, c1, 0, 1, 2, 3, 4, 5, 6, 7), pf, o1);
            }
        }
    }
    const float inv = 1.0f / l;
    LAS unsigned char* wl = L + AT_WO + w * AT_WOB;
#pragma unroll
    for (int g = 0; g < 4; ++g) {
        const bf16x4_t w0 = __builtin_convertvector((f32x4){o0[4 * g] * inv, o0[4 * g + 1] * inv, o0[4 * g + 2] * inv, o0[4 * g + 3] * inv}, bf16x4_t);
        const bf16x4_t w1 = __builtin_convertvector((f32x4){o1[4 * g] * inv, o1[4 * g + 1] * inv, o1[4 * g + 2] * inv, o1[4 * g + 3] * inv}, bf16x4_t);
        *(LAS v2u*)(wl + c * ATT_OSTR + (8 * g + 4 * h2) * 2) = __builtin_bit_cast(v2u, w0);
        *(LAS v2u*)(wl + c * ATT_OSTR + (32 + 8 * g + 4 * h2) * 2) = __builtin_bit_cast(v2u, w1);
    }
    bf16* ob = op + (size_t)p * NT * DH + (size_t)t.b * SEQ * DH + t.h * 64;
#pragma unroll
    for (int i = 0; i < 4; ++i) { const int row = (lane >> 3) + 8 * i; const v4u wv = *(const LAS v4u*)(wl + row * ATT_OSTR + (lane & 7) * 16);
        const int tok = ((m0 + row) << dsh) + r; *(v4u*)(ob + (size_t)tok * DH + 8 * (lane & 7)) = wv; }
    if (h2 == 0) lse[(size_t)p * NT * 8 + (size_t)(t.b * SEQ + tq) * 8 + t.h] = mx + __builtin_amdgcn_logf(l) * LN2;
}
__device__ __forceinline__ void attn_items(const Args& a, const Frame& F) {
    const bf16* proj = (const bf16*)(a.ws + WS_PROJ); bf16* op = (bf16*)(a.ws + WS_OP); float* lse = (float*)(a.ws + WS_LSE);
    LAS unsigned char* L = F.lds; const int lane = F.lane, w = F.wave, c = lane & 31, h2 = lane >> 5;
    const bf16* kvb = (const bf16*)(a.ws + WS_KV); const bf16* qhb = (const bf16*)(a.ws + WS_QH);
    v4u kr[12];
#pragma unroll
    for (int n = 0; n < 12; ++n) kr[n] = (v4u){0u, 0u, 0u, 0u};
    const bool xl = (F.G % 8 == 0) && (ATT_ITEMS % (F.G / 8) == 0 || true);
    const int nlb = xl ? F.G / 8 : F.G, lb = xl ? (F.bid >> 3) : F.bid, xc = xl ? (F.bid & 7) : 0;
#define ATT_ITEM_OF(n_) (xl ? ((((lb + nlb * (n_)) / 48) * 8 + xc) * 48 + (lb + nlb * (n_)) % 48) : (lb + nlb * (n_)))
    const int nit = xl ? (ATT_ITEMS / 8 - lb + nlb - 1) / nlb : (ATT_ITEMS - lb + nlb - 1) / nlb;
    int item = nit > 0 ? ATT_ITEM_OF(0) : ATT_ITEMS;
    if (nit > 0) { const AttItem t0 = att_decode(item); att_load(kvb, t0, F.tid, kr); }
    bf16x8 qf[4], qn[4];
#define ATT_QLOAD(dst, t_) do { const int tq_ = (((t_).m0 + 32 * w + c) << (t_).dsh) + (t_).r; const bf16* qp_ = qhb + ((size_t)((t_).b * 8 + (t_).h) * SEQ + tq_) * 64 + 8 * h2; \
        _Pragma("unroll") for (int s_ = 0; s_ < 4; ++s_) dst[s_] = *(const bf16x8*)(qp_ + 16 * s_); } while (0)
#pragma unroll
    for (int s = 0; s < 4; ++s) { qf[s] = (bf16x8){0, 0, 0, 0, 0, 0, 0, 0}; qn[s] = qf[s]; }
    if (nit > 0) { const AttItem t0 = att_decode(item); ATT_QLOAD(qf, t0); }
#pragma unroll 1
    for (int n = 0; n < nit; ++n) {
        const AttItem t = att_decode(item);
        att_stage(L, F.tid, kr);
        __syncthreads();
        if (n + 1 < nit) { item = ATT_ITEM_OF(n + 1); const AttItem tn = att_decode(item); att_load(kvb, tn, F.tid, kr); ATT_QLOAD(qn, tn); }
        bf16x8 pfr[5][2]; float mx, l;
        if (!((PROBE_SKIP & 16) && a.li == 1)) {
        att_scores(L, t, qf, pfr, mx, l, w, lane);
        if (!((PROBE_SKIP & 8) && a.li == 1)) att_pv(op, lse, L, t, pfr, mx, l, w, lane);
        }
#pragma unroll
        for (int s = 0; s < 4; ++s) qf[s] = qn[s];
        __syncthreads();
    }
#undef ATT_QLOAD
#undef ATT_ITEM_OF
}

__device__ __forceinline__ void attn_combine(const Args& a, const Frame& F) {
    const bf16* op = (const bf16*)(a.ws + WS_OP); const float* lse = (const float*)(a.ws + WS_LSE); bf16* mix = (bf16*)(a.ws + WS_MIX);
    const int gw = F.bid * NWAVES + F.wave, NGW = F.G * NWAVES, lane = F.lane, hh = lane >> 3, d0 = 8 * (lane & 7);
    f32x4 g0 = *(const f32x4*)(a.attn_g + hh * 64 + d0), g1 = *(const f32x4*)(a.attn_g + hh * 64 + d0 + 4);
    for (int t = gw; t < NT; t += NGW) {
        const float l0 = lse[(size_t)t * 8 + hh], l1 = lse[(size_t)NT * 8 + (size_t)t * 8 + hh], l2 = lse[(size_t)2 * NT * 8 + (size_t)t * 8 + hh];
        const float mx = fmaxf(l0, fmaxf(l1, l2)); const float e0 = __expf(l0 - mx), e1 = __expf(l1 - mx), e2 = __expf(l2 - mx); const float inv = 1.0f / (e0 + e1 + e2);
        const v4u w0 = *(const v4u*)(op + (size_t)t * DH + hh * 64 + d0), w1 = *(const v4u*)(op + (size_t)NT * DH + (size_t)t * DH + hh * 64 + d0), w2 = *(const v4u*)(op + (size_t)2 * NT * DH + (size_t)t * DH + hh * 64 + d0);
        float o[8]; const float a0 = e0 * inv, a1 = e1 * inv, a2 = e2 * inv;
        o[0] = a0 * bflo(w0.x) + a1 * bflo(w1.x) + a2 * bflo(w2.x); o[1] = a0 * bfhi(w0.x) + a1 * bfhi(w1.x) + a2 * bfhi(w2.x);
        o[2] = a0 * bflo(w0.y) + a1 * bflo(w1.y) + a2 * bflo(w2.y); o[3] = a0 * bfhi(w0.y) + a1 * bfhi(w1.y) + a2 * bfhi(w2.y);
        o[4] = a0 * bflo(w0.z) + a1 * bflo(w1.z) + a2 * bflo(w2.z); o[5] = a0 * bfhi(w0.z) + a1 * bfhi(w1.z) + a2 * bfhi(w2.z);
        o[6] = a0 * bflo(w0.w) + a1 * bflo(w1.w) + a2 * bflo(w2.w); o[7] = a0 * bfhi(w0.w) + a1 * bfhi(w1.w) + a2 * bfhi(w2.w);
        float ss = 0.f;
#pragma unroll
        for (int j = 0; j < 8; ++j) ss += o[j] * o[j];
        ss += __shfl_xor(ss, 1); ss += __shfl_xor(ss, 2); ss += __shfl_xor(ss, 4);
        const float rn = 1.0f / sqrtf(ss * (1.0f / 64.0f) + EPS);
        v4u w; w.x = pk2(o[0] * rn * g0.x, o[1] * rn * g0.y); w.y = pk2(o[2] * rn * g0.z, o[3] * rn * g0.w); w.z = pk2(o[4] * rn * g1.x, o[5] * rn * g1.y); w.w = pk2(o[6] * rn * g1.z, o[7] * rn * g1.w);
        *(v4u*)(mix + (size_t)t * DM + DH + hh * 64 + d0) = w;
    }
}

#ifndef FAST_ATTN
#define FAST_ATTN 1
#endif
constexpr int HG_LB = 0, HG_QT = 32768, HG_KT = 49152, HG_VV = 65536, HG_SM = 81920, HG_TOT = 114688, HG_PRE = 116736, HG_BMID = 118784, HG_EMID = 119296, HG_DLAST = 119808, HG_CFAC = 120320, HG_LBV = 120832, HG_GNV = 121344;
#define HSWZ(row, ch) (256 * (row) + 16 * ((ch) ^ ((((row) & 3) << 2) | (((row) >> 2) & 3))))
__device__ __forceinline__ float bfel(const v4u& w, int j) { const unsigned x = (j >> 1) == 0 ? w.x : (j >> 1) == 1 ? w.y : (j >> 1) == 2 ? w.z : w.w; return (j & 1) ? bfhi(x) : bflo(x); }

constexpr int HG_BSV = 121856, HG_BSC = 122368;
constexpr int HG_NSEG = 8, HG_SEGCH = SEQ / 64 / HG_NSEG;
__device__ __forceinline__ void hgrn_chunked(const Args& a, const Frame& F, int item) {
    const int seg = item & 7, h = (item >> 3) & 3, b = item >> 5;
    const bf16* proj = (const bf16*)(a.ws + WS_PROJ); bf16* oa = (bf16*)(a.ws + WS_OA); bf16* qpp = (bf16*)(a.ws + WS_QPP);
    LAS unsigned char* L = F.lds;
    const int tid = F.tid, lane = F.lane, w = F.wave, tt = w >> 2, vt = w & 3, c = lane & 31, h2 = lane >> 5;
    const int et = tid >> 3, ec = tid & 7;
    const int g4 = lane >> 4, i16 = lane & 15, q4 = i16 >> 2, p4 = i16 & 3, blk = g4 & 1, pe = ((p4 & 1) << 1) | (p4 >> 1);
    LAS float* LB = (LAS float*)(L + HG_LB); LAS float* TOT = (LAS float*)(L + HG_TOT); LAS float* PRE = (LAS float*)(L + HG_PRE);
    LAS float* BMID = (LAS float*)(L + HG_BMID); LAS float* EMID = (LAS float*)(L + HG_EMID); LAS float* DLAST = (LAS float*)(L + HG_DLAST); LAS float* CFAC = (LAS float*)(L + HG_CFAC);
    LAS float* LBV = (LAS float*)(L + HG_LBV); LAS float* BSV = (LAS float*)(L + HG_BSV); LAS float* BSC = (LAS float*)(L + HG_BSC);
    if (tid < 128) { const float l0 = a.lb_logits[h * 128 + tid], l1 = a.lb_logits[DH + h * 128 + tid]; LBV[tid] = 1.0f / (1.0f + __expf(l1 - l0)); BSV[tid] = 0.f; }
    f32x16 S0, S1;
#pragma unroll
    for (int i = 0; i < 16; ++i) { S0[i] = 0.f; S1[i] = 0.f; }
    const int tok0 = b * SEQ + seg * (SEQ / HG_NSEG);
    const bf16* prow = proj + (size_t)(tok0 + et) * DPROJ + h * 128;
    v4u pq[2], pf[2], pv[2];
#pragma unroll
    for (int i = 0; i < 2; ++i) { pq[i] = *(const v4u*)(prow + C_HQ + 8 * (ec + 8 * i)); pf[i] = *(const v4u*)(prow + C_HF + 8 * (ec + 8 * i)); pv[i] = *(const v4u*)(prow + C_HI + 8 * (ec + 8 * i)); }
    __syncthreads();
#pragma unroll 1
    for (int ch = 0; ch < HG_SEGCH; ++ch) {
        int lane_ = lane, tid_ = tid; asm volatile("" : "+v"(lane_), "+v"(tid_));
        const int c = lane_ & 31, h2 = lane_ >> 5, et = tid_ >> 3, ec = tid_ & 7;
        const int g4 = lane_ >> 4, i16 = lane_ & 15, q4 = i16 >> 2, p4 = i16 & 3, blk = g4 & 1, pe = ((p4 & 1) << 1) | (p4 >> 1);
        const bf16* crow_ = prow + (size_t)ch * 64 * DPROJ;
        float kf_[16];
#pragma unroll
        for (int i = 0; i < 2; ++i) { const int ci = ec + 8 * i; float lf[8];
#pragma unroll
            for (int j = 0; j < 8; ++j) { const float fl = bfel(pf[i], j), lb = LBV[8 * ci + j]; const float f = lb + (1.0f - lb) * __builtin_amdgcn_rcpf(1.0f + __builtin_amdgcn_exp2f(-fl * LOG2E)); kf_[8 * i + j] = 1.0f - f; lf[j] = __builtin_amdgcn_logf(f) * LN2; }
            *(LAS f32x4*)(LB + et * 128 + 8 * ci) = (f32x4){lf[0], lf[1], lf[2], lf[3]}; *(LAS f32x4*)(LB + et * 128 + 8 * ci + 4) = (f32x4){lf[4], lf[5], lf[6], lf[7]};
            *(LAS v4u*)(L + HG_VV + HSWZ(et, ci)) = pv[i]; }
        __syncthreads();
        { const int k = tid & 127, part = tid >> 7; float run = 0.f;
#pragma unroll
          for (int r = 0; r < 16; ++r) { const int row = 16 * part + r; run += LB[row * 128 + k]; LB[row * 128 + k] = run; }
          TOT[part * 128 + k] = run; }
        __syncthreads();
        if (tid < 128) { const float t0 = TOT[tid], t1 = TOT[128 + tid], t2 = TOT[256 + tid]; PRE[tid] = 0.f; PRE[128 + tid] = t0; PRE[256 + tid] = t0 + t1; PRE[384 + tid] = t0 + t1 + t2;
            const float bmr = LB[31 * 128 + tid] + t0, bl = LB[63 * 128 + tid] + t0 + t1 + t2; const float bm = fmaxf(bmr, -80.0f);
            BMID[tid] = bm; EMID[tid] = __builtin_amdgcn_exp2f(bm * LOG2E); DLAST[tid] = __builtin_amdgcn_exp2f(bl * LOG2E); CFAC[tid] = __builtin_amdgcn_exp2f((bl - bm) * LOG2E);
            const float bs = BSV[tid]; BSC[tid] = bs; BSV[tid] = bs + bl; }
        __syncthreads();
#pragma unroll
        for (int i = 0; i < 2; ++i) { const int ci = ec + 8 * i; f32x8 qv, kv, qs;
#pragma unroll
            for (int j = 0; j < 8; ++j) { const float bb = LB[et * 128 + 8 * ci + j] + PRE[(et >> 4) * 128 + 8 * ci + j], bm = BMID[8 * ci + j];
                const float e1 = __builtin_amdgcn_exp2f(fminf(bb - bm, 80.0f) * LOG2E), e2 = __builtin_amdgcn_exp2f(fminf(bm - bb, 80.0f) * LOG2E);
                const float qq = bfel(pq[i], j); qv[j] = qq * e1; kv[j] = kf_[8 * i + j] * e2; qs[j] = qq * __builtin_amdgcn_exp2f((bb + BSC[8 * ci + j]) * LOG2E); }
            *(bf16x8*)(qpp + (size_t)(tok0 + ch * 64 + et) * DH + h * 128 + 8 * ci) = __builtin_bit_cast(bf16x8, __builtin_convertvector(qs, bf16x8_t));
            *(LAS bf16x8*)(L + HG_QT + HSWZ(et, ci)) = __builtin_bit_cast(bf16x8, __builtin_convertvector(qv, bf16x8_t));
            *(LAS bf16x8*)(L + HG_KT + HSWZ(et, ci)) = __builtin_bit_cast(bf16x8, __builtin_convertvector(kv, bf16x8_t)); }
#pragma unroll
        for (int tile = 0; tile < 2; ++tile) { const int kt = 2 * tt + tile; f32x16 sm;
#pragma unroll
            for (int i = 0; i < 16; ++i) { const int kp = 32 * kt + (i & 3) + 4 * ((i >> 2) & 1) + 8 * h2 + 16 * (i >> 3); sm[i] = (tile == 0 ? S0[i] : S1[i]) * EMID[kp]; }
            *(LAS bf16x8*)(L + HG_SM + ((kt * 4 + vt) * 2 + 0) * 1024 + lane * 16) = PACK8(sm, 0);
            *(LAS bf16x8*)(L + HG_SM + ((kt * 4 + vt) * 2 + 1) * 1024 + lane * 16) = PACK8(sm, 1); }
        if (ch + 1 < SEQ / 64) { const bf16* nrow = crow_ + (size_t)64 * DPROJ;
#pragma unroll
            for (int i = 0; i < 2; ++i) { pq[i] = *(const v4u*)(nrow + C_HQ + 8 * (ec + 8 * i)); pf[i] = *(const v4u*)(nrow + C_HF + 8 * (ec + 8 * i)); pv[i] = *(const v4u*)(nrow + C_HI + 8 * (ec + 8 * i)); } }
        __syncthreads();
        bf16x8 qfr[8];
#pragma unroll
        for (int s = 0; s < 8; ++s) qfr[s] = *(const LAS bf16x8*)(L + HG_QT + HSWZ(32 * tt + c, 2 * s + h2));
        f32x16 O;
#pragma unroll
        for (int i = 0; i < 16; ++i) O[i] = 0.f;
#pragma unroll
        for (int st = 0; st < 2; ++st) {
            if (st <= tt) {
                f32x16 x1;
#pragma unroll
                for (int i = 0; i < 16; ++i) x1[i] = 0.f;
#pragma unroll
                for (int s = 0; s < 8; ++s) { const bf16x8 kfr = *(const LAS bf16x8*)(L + HG_KT + HSWZ(32 * st + c, 2 * s + h2)); x1 = MFMA32(kfr, qfr[s], x1); }
                if (st == tt) {
#pragma unroll
                    for (int i = 0; i < 16; ++i) x1[i] = (crow(i, h2) <= c) ? x1[i] : 0.f; }
#pragma unroll
                for (int s = 0; s < 2; ++s) {
                    const bf16x8 pfr = PACK8(x1, s);
                    const s16x4 v0 = TR16(L + HG_VV + HSWZ(32 * st + 16 * s + 4 * h2 + q4, 4 * vt + 2 * blk + (p4 >> 1)) + 8 * (p4 & 1));
                    const s16x4 v1 = TR16(L + HG_VV + HSWZ(32 * st + 16 * s + 8 + 4 * h2 + q4, 4 * vt + 2 * blk + (p4 >> 1)) + 8 * (p4 & 1));
                    O = MFMA32(pfr, __builtin_shufflevector(v0, v1, 0, 1, 2, 3, 4, 5, 6, 7), O);
                }
            }
        }
#pragma unroll
        for (int kt = 0; kt < 4; ++kt)
#pragma unroll
            for (int s = 0; s < 2; ++s) { const bf16x8 smf = *(const LAS bf16x8*)(L + HG_SM + ((kt * 4 + vt) * 2 + s) * 1024 + lane * 16); O = MFMA32(qfr[2 * kt + s], smf, O); }
#pragma unroll
        for (int tile = 0; tile < 2; ++tile) { const int kt = 2 * tt + tile; f32x16 wv;
#pragma unroll
            for (int i = 0; i < 16; ++i) wv[i] = 0.f;
#pragma unroll
            for (int s = 0; s < 4; ++s) {
                const s16x4 a0 = TR16(L + HG_KT + HSWZ(16 * s + 8 * h2 + q4, 4 * kt + 2 * blk + (pe >> 1)) + 8 * (pe & 1));
                const s16x4 a1 = TR16(L + HG_KT + HSWZ(16 * s + 8 * h2 + 4 + q4, 4 * kt + 2 * blk + (pe >> 1)) + 8 * (pe & 1));
                const s16x4 b0 = TR16(L + HG_VV + HSWZ(16 * s + 8 * h2 + q4, 4 * vt + 2 * blk + (p4 >> 1)) + 8 * (p4 & 1));
                const s16x4 b1 = TR16(L + HG_VV + HSWZ(16 * s + 8 * h2 + 4 + q4, 4 * vt + 2 * blk + (p4 >> 1)) + 8 * (p4 & 1));
                wv = MFMA32(__builtin_shufflevector(a0, a1, 0, 1, 2, 3, 4, 5, 6, 7), __builtin_shufflevector(b0, b1, 0, 1, 2, 3, 4, 5, 6, 7), wv);
            }
#pragma unroll
            for (int i = 0; i < 16; ++i) { const int kp = 32 * kt + (i & 3) + 4 * ((i >> 2) & 1) + 8 * h2 + 16 * (i >> 3); const float d = DLAST[kp], cf = CFAC[kp];
                if (tile == 0) S0[i] = d * S0[i] + cf * wv[i]; else S1[i] = d * S1[i] + cf * wv[i]; } }
#pragma unroll
        for (int i = 0; i < 16; ++i) LB[(32 * tt + crow(i, h2)) * 128 + 32 * vt + c] = O[i];
        __syncthreads();
        { bf16* orow = oa + (size_t)(tok0 + ch * 64 + et) * DH + h * 128;
#pragma unroll
          for (int i = 0; i < 4; ++i) { const f32x4 o4 = *(const LAS f32x4*)(LB + et * 128 + 4 * ec + 32 * i);
              *(v2u*)(orow + 4 * ec + 32 * i) = __builtin_bit_cast(v2u, __builtin_convertvector(o4, bf16x4_t)); } }
        __syncthreads();
    }
    { float* ss = (float*)(a.ws + WS_SEGS) + (size_t)item * 16384 + (size_t)w * 2048;
#pragma unroll
      for (int i = 0; i < 16; ++i) { ss[i * 64 + lane] = S0[i]; ss[1024 + i * 64 + lane] = S1[i]; }
      if (tid < 128) ((float*)(a.ws + WS_SEGD))[item * 128 + tid] = __builtin_amdgcn_exp2f(BSV[tid] * LOG2E); }
    __syncthreads();
}

__device__ __forceinline__ void hgrn_fixup(const Args& a, const Frame& F, int item) {
    const int seg = item & 7, h = (item >> 3) & 3, b = item >> 5;
    const bf16* proj = (const bf16*)(a.ws + WS_PROJ); const bf16* oa = (const bf16*)(a.ws + WS_OA); const bf16* qpp = (const bf16*)(a.ws + WS_QPP); bf16* mix = (bf16*)(a.ws + WS_MIX);
    LAS unsigned char* L = F.lds;
    const int tid = F.tid, lane = F.lane, w = F.wave, tt = w >> 2, vt = w & 3, c = lane & 31, h2 = lane >> 5;
    const int et = tid >> 3, ec = tid & 7;
    LAS float* LB = (LAS float*)(L + HG_LB); LAS float* GNV = (LAS float*)(L + HG_GNV);
    if (tid < 128) GNV[tid] = a.hgrn_g[h * 128 + tid];
    f32x16 S0, S1;
#pragma unroll
    for (int i = 0; i < 16; ++i) { S0[i] = 0.f; S1[i] = 0.f; }
#pragma unroll 4
    for (int sg = 0; sg < seg; ++sg) { const int it2 = (item & ~7) + sg;
        const float* ss = (const float*)(a.ws + WS_SEGS) + (size_t)it2 * 16384 + (size_t)w * 2048; const float* dd = (const float*)(a.ws + WS_SEGD) + it2 * 128;
#pragma unroll
        for (int i = 0; i < 16; ++i) { const int kl = (i & 3) + 4 * ((i >> 2) & 1) + 8 * h2 + 16 * (i >> 3);
            S0[i] = dd[32 * (2 * tt) + kl] * S0[i] + ss[i * 64 + lane]; S1[i] = dd[32 * (2 * tt + 1) + kl] * S1[i] + ss[1024 + i * 64 + lane]; } }
    *(LAS bf16x8*)(L + HG_SM + (((2 * tt) * 4 + vt) * 2 + 0) * 1024 + lane * 16) = PACK8(S0, 0); *(LAS bf16x8*)(L + HG_SM + (((2 * tt) * 4 + vt) * 2 + 1) * 1024 + lane * 16) = PACK8(S0, 1);
    *(LAS bf16x8*)(L + HG_SM + (((2 * tt + 1) * 4 + vt) * 2 + 0) * 1024 + lane * 16) = PACK8(S1, 0); *(LAS bf16x8*)(L + HG_SM + (((2 * tt + 1) * 4 + vt) * 2 + 1) * 1024 + lane * 16) = PACK8(S1, 1);
    __syncthreads();
    bf16x8 smf[8];
#pragma unroll
    for (int i = 0; i < 8; ++i) smf[i] = *(const LAS bf16x8*)(L + HG_SM + (((i >> 1) * 4 + vt) * 2 + (i & 1)) * 1024 + lane * 16);
    const int tok0 = b * SEQ + seg * (SEQ / HG_NSEG);
    v2u pg[4], po[4]; bf16x8 qfr[8];
#pragma unroll
    for (int i = 0; i < 8; ++i) qfr[i] = (bf16x8){0, 0, 0, 0, 0, 0, 0, 0};
#define FX_LOAD(tokc_) do { _Pragma("unroll") for (int i = 0; i < 4; ++i) { pg[i] = *(const v2u*)(proj + (size_t)((tokc_) + et) * DPROJ + C_HG + h * 128 + 4 * ec + 32 * i); po[i] = *(const v2u*)(oa + (size_t)((tokc_) + et) * DH + h * 128 + 4 * ec + 32 * i); } \
        if (seg > 0) { const bf16* qp = qpp + (size_t)((tokc_) + 32 * tt + c) * DH + h * 128 + 8 * h2; _Pragma("unroll") for (int i = 0; i < 8; ++i) qfr[i] = *(const bf16x8*)(qp + 16 * i); } } while (0)
    FX_LOAD(tok0);
#pragma unroll 1
    for (int ch = 0; ch < HG_SEGCH; ++ch) {
        const int tokc = tok0 + ch * 64;
        f32x16 O;
#pragma unroll
        for (int i = 0; i < 16; ++i) O[i] = 0.f;
        if (seg > 0) {
#pragma unroll
            for (int i = 0; i < 8; ++i) O = MFMA32(qfr[i], smf[i], O);
        }
        v2u cg[4], co[4];
#pragma unroll
        for (int i = 0; i < 4; ++i) { cg[i] = pg[i]; co[i] = po[i]; }
        if (ch + 1 < HG_SEGCH) FX_LOAD(tokc + 64);
#pragma unroll
        for (int i = 0; i < 16; ++i) LB[(32 * tt + crow(i, h2)) * 128 + 32 * vt + c] = O[i];
        __syncthreads();
        { f32x4 o4[4]; float ssq = 0.f;
#pragma unroll
          for (int i = 0; i < 4; ++i) { o4[i] = *(const LAS f32x4*)(LB + et * 128 + 4 * ec + 32 * i);
              o4[i].x += bflo(co[i].x); o4[i].y += bfhi(co[i].x); o4[i].z += bflo(co[i].y); o4[i].w += bfhi(co[i].y);
              ssq += (o4[i].x * o4[i].x + o4[i].y * o4[i].y) + (o4[i].z * o4[i].z + o4[i].w * o4[i].w); }
          ssq += __shfl_xor(ssq, 1); ssq += __shfl_xor(ssq, 2); ssq += __shfl_xor(ssq, 4);
          const float rn = 1.0f / sqrtf(ssq * (1.0f / 128.0f) + EPS);
          bf16* orow = mix + (size_t)(tokc + et) * DM + h * 128;
#pragma unroll
          for (int i = 0; i < 4; ++i) { const f32x4 gn = *(const LAS f32x4*)(GNV + 4 * ec + 32 * i);
              const float g0 = bflo(cg[i].x), g1 = bfhi(cg[i].x), g2 = bflo(cg[i].y), g3 = bfhi(cg[i].y);
              const float s0 = g0 * __builtin_amdgcn_rcpf(1.0f + __builtin_amdgcn_exp2f(-g0 * LOG2E)), s1 = g1 * __builtin_amdgcn_rcpf(1.0f + __builtin_amdgcn_exp2f(-g1 * LOG2E));
              const float s2 = g2 * __builtin_amdgcn_rcpf(1.0f + __builtin_amdgcn_exp2f(-g2 * LOG2E)), s3 = g3 * __builtin_amdgcn_rcpf(1.0f + __builtin_amdgcn_exp2f(-g3 * LOG2E));
              const bf16x4_t ov = __builtin_convertvector((f32x4){o4[i].x * rn * gn.x * s0, o4[i].y * rn * gn.y * s1, o4[i].z * rn * gn.z * s2, o4[i].w * rn * gn.w * s3}, bf16x4_t);
              *(v2u*)(orow + 4 * ec + 32 * i) = __builtin_bit_cast(v2u, ov); } }
        __syncthreads();
    }
#undef FX_LOAD
}

#ifndef FAST_HGRN
#define FAST_HGRN 1
#endif
__device__ __forceinline__ void phase2(const Args& a, const Frame& F) {
    const bool attn_first = false;
#pragma unroll 1
    for (int step = 0; step < 2; ++step) {
        Frame F2 = F; { int t_ = F.tid; asm volatile("" : "+v"(t_)); F2.tid = t_; F2.lane = t_ & 63; }
        if ((step == 0) == attn_first) { if (!((PROBE_SKIP & 1) && a.li == 1)) attn_items(a, F2); }
        else { for (int it = F.bid; it < NBATCH * 4 * HG_NSEG; it += F.G) hgrn_chunked(a, F2, it); }
    }
}
__device__ __forceinline__ void phase2b(const Args& a, const Frame& F) {
    if (!((PROBE_SKIP & 2) && a.li == 1)) for (int it = F.bid; it < NBATCH * 4 * HG_NSEG; it += F.G) hgrn_fixup(a, F, it);
    if (!((PROBE_SKIP & 4) && a.li == 1)) attn_combine(a, F);
}

__device__ __forceinline__ void phase3(const Args& a, const Frame& F) {
    const bf16* mix = (const bf16*)(a.ws + WS_MIX); const bf16* wout = (const bf16*)(a.ws + WS_WOUT);
#if FAST_GEMM
    { pg8::DenseSched S{mix, wout, NT / 256, DM / 256, F.G, F.bid, DM * 2}; pg8::EpiRes E{a.x, a.out}; pg8::gemm_phase<pg8::EpiRes, pg8::DenseSched, true>(F.lds, DM * 2, S, E, a.ws, a.li == 1); return; }
#endif
    constexpr int NPN = DM / 128, NU = (NT / 256) * NPN;
    for (int u = F.bid; u < NU; u += F.G) {
        const int pm = u / NPN, pn = u % NPN;
        const bf16* A0 = mix + (size_t)pm * 256 * DM;
        auto rp = [&](int r) { return A0 + (size_t)r * DM; };
        const float* X = a.x + (size_t)pm * 256 * DM + pn * 128; float* O = a.out + (size_t)pm * 256 * DM + pn * 128;
        auto epi = [&](int r, int c, const f32x4& v) { const f32x4 xv = *(const f32x4*)(X + (size_t)r * DM + c); *(f32x4*)(O + (size_t)r * DM + c) = xv + v; };
        gemm_unit_simple(rp, wout + (size_t)pn * 128 * DM, DM, epi, F.wave, F.lane);
    }
}

__device__ __forceinline__ void phase4(const Args& a, const Frame& F) {
    LAS float* WrT = (LAS float*)F.lds;
    LAS unsigned* hist = (LAS unsigned*)(F.lds + 131072);
    for (int i = F.tid; i < DM * NE / 4; i += NTHR) { const f32x4 w = ((const f32x4*)a.router_w)[i]; const int k = i >> 3, e0 = (i & 7) * 4;
        WrT[(e0 + 0) * DM + k] = w.x; WrT[(e0 + 1) * DM + k] = w.y; WrT[(e0 + 2) * DM + k] = w.z; WrT[(e0 + 3) * DM + k] = w.w; }
    if (F.tid < 32) hist[F.tid] = 0u;
    __syncthreads();
    bf16* h2 = (bf16*)(a.ws + WS_XN); int* topi = (int*)(a.ws + WS_TOPI); float* gate = (float*)(a.ws + WS_GATE);
    const int TPB = (NT + F.G - 1) / F.G; const int lane = F.lane;
    for (int tt = F.wave; tt < TPB; tt += NWAVES) {
        const int t = F.bid * TPB + tt; if (t >= NT) break;
        const f32x4* xr = (const f32x4*)(a.out + (size_t)t * DM) + lane; const f32x4* gr = (const f32x4*)a.norm2_g + lane;
        f32x4 hv[4]; float s = 0.f;
#pragma unroll
        for (int j = 0; j < 4; ++j) { hv[j] = xr[64 * j]; s += (hv[j].x * hv[j].x + hv[j].y * hv[j].y) + (hv[j].z * hv[j].z + hv[j].w * hv[j].w); }
        const float r = 1.0f / sqrtf(wave_sum(s) * (1.f / DM) + EPS);
        v2u* o8 = (v2u*)(h2 + (size_t)t * DM) + lane;
#pragma unroll
        for (int j = 0; j < 4; ++j) { const f32x4 g = gr[64 * j]; hv[j].x *= r * g.x; hv[j].y *= r * g.y; hv[j].z *= r * g.z; hv[j].w *= r * g.w;
            v2u w; w.x = pk2(hv[j].x, hv[j].y); w.y = pk2(hv[j].z, hv[j].w); o8[64 * j] = w; }
        float pv[32];
#pragma unroll
        for (int e = 0; e < 32; ++e) { float acc = 0.f;
#pragma unroll
            for (int j = 0; j < 4; ++j) { const f32x4 w = *(const LAS f32x4*)(WrT + e * DM + 4 * lane + 256 * j); acc += (hv[j].x * w.x + hv[j].y * w.y) + (hv[j].z * w.z + hv[j].w * w.w); }
            pv[e] = acc; }
#define RS_STEP(OFF, N) { const bool up = (lane & (OFF)) != 0; _Pragma("unroll") for (int i = 0; i < (N); ++i) { const float send = up ? pv[i] : pv[i + (N)]; const float keep = up ? pv[i + (N)] : pv[i]; pv[i] = keep + __shfl_xor(send, (OFF)); } }
        RS_STEP(32, 16) RS_STEP(16, 8) RS_STEP(8, 4) RS_STEP(4, 2) RS_STEP(2, 1)
#undef RS_STEP
        float lg = pv[0] + __shfl_xor(pv[0], 1);
        const int me = lane >> 1; lg += a.router_b[me];
        float tv[4]; int ti[4]; float cur = lg;
#pragma unroll
        for (int k = 0; k < 4; ++k) { float bv = cur; int bi = me;
#pragma unroll
            for (int o = 1; o < 64; o <<= 1) { const float ov = __shfl_xor(bv, o); const int oi = __shfl_xor(bi, o); const bool tk = (ov > bv) | ((ov == bv) & (oi < bi)); bv = tk ? ov : bv; bi = tk ? oi : bi; }
            tv[k] = bv; ti[k] = bi; if (me == bi) cur = -INFINITY; }
        const float e1 = __expf(tv[1] - tv[0]), e2 = __expf(tv[2] - tv[0]), e3 = __expf(tv[3] - tv[0]); const float inv = 1.0f / (1.0f + e1 + e2 + e3);
        if (lane == 0) { *(int4*)(topi + (size_t)t * 4) = make_int4(ti[0], ti[1], ti[2], ti[3]); *(f32x4*)(gate + (size_t)t * 4) = (f32x4){inv, e1 * inv, e2 * inv, e3 * inv}; }
        if (lane < 4) { const int e = lane == 0 ? ti[0] : lane == 1 ? ti[1] : lane == 2 ? ti[2] : ti[3]; atomicAdd((unsigned*)&hist[e], 1u); }
    }
    __syncthreads();
    if (F.tid < 32) ((int*)(a.ws + WS_BC))[F.bid * 32 + F.tid] = (int)hist[F.tid];
    __syncthreads();
}

__device__ __forceinline__ void phase4_mfma(const Args& a, const Frame& F) {
    LAS float* WG = (LAS float*)F.lds;
    LAS unsigned* hist = (LAS unsigned*)(F.lds + 131072);
    for (int i = F.tid; i < DM * NE / 4; i += NTHR) { const f32x4 wv = ((const f32x4*)a.router_w)[i]; const float g = a.norm2_g[i >> 3]; *(LAS f32x4*)(WG + 4 * i) = wv * g; }
    if (F.tid < 32) hist[F.tid] = 0u;
    __syncthreads();
    bf16* h2 = (bf16*)(a.ws + WS_XN); int* topi = (int*)(a.ws + WS_TOPI); float* gate = (float*)(a.ws + WS_GATE);
    const int TPB = (NT + F.G - 1) / F.G; const int lane = F.lane;
    if (F.wave < 4) {
        const int tokl = lane & 31, half = lane >> 5;
        for (int j = F.wave; j * 32 < TPB; j += 4) {
            const int t = F.bid * TPB + j * 32 + tokl; if (F.bid * TPB + j * 32 >= NT) break;
            const float* xrow = a.out + (size_t)t * DM + 4 * half;
            f32x16 acc;
#pragma unroll
            for (int i = 0; i < 16; ++i) acc[i] = 0.f;
            float ss = 0.f;
#pragma unroll 8
            for (int m = 0; m < 128; ++m) { const f32x4 xv = *(const f32x4*)(xrow + 8 * m); ss += (xv.x * xv.x + xv.y * xv.y) + (xv.z * xv.z + xv.w * xv.w);
                const LAS float* wp = WG + (8 * m + 4 * half) * 32 + tokl;
                acc = __builtin_amdgcn_mfma_f32_32x32x2f32(wp[0], xv.x, acc, 0, 0, 0); acc = __builtin_amdgcn_mfma_f32_32x32x2f32(wp[32], xv.y, acc, 0, 0, 0);
                acc = __builtin_amdgcn_mfma_f32_32x32x2f32(wp[64], xv.z, acc, 0, 0, 0); acc = __builtin_amdgcn_mfma_f32_32x32x2f32(wp[96], xv.w, acc, 0, 0, 0); }
            ss += __shfl_xor(ss, 32);
            const float r = 1.0f / sqrtf(ss * (1.f / DM) + EPS);
            float v[16];
#pragma unroll
            for (int i = 0; i < 16; ++i) v[i] = acc[i] * r + a.router_b[crow(i, half)];
            float tv[8]; int ti[8];
#pragma unroll
            for (int k = 0; k < 4; ++k) { float bv = -INFINITY; int bi = 0;
#pragma unroll
                for (int i = 0; i < 16; ++i) { const bool tk = v[i] > bv; bv = tk ? v[i] : bv; bi = tk ? i : bi; }
#pragma unroll
                for (int i = 0; i < 16; ++i) v[i] = (i == bi) ? -INFINITY : v[i];
                tv[k] = bv; ti[k] = (bi & 3) + 8 * (bi >> 2) + 4 * half; }
#pragma unroll
            for (int k = 0; k < 4; ++k) { tv[4 + k] = __shfl_xor(tv[k], 32); ti[4 + k] = __shfl_xor(ti[k], 32); }
            float gv[4]; int gi[4];
#pragma unroll
            for (int k = 0; k < 4; ++k) { float bv = -INFINITY; int bi = 1 << 30; int bs = 0;
#pragma unroll
                for (int i = 0; i < 8; ++i) { const bool tk = (tv[i] > bv) | ((tv[i] == bv) & (ti[i] < bi)); bv = tk ? tv[i] : bv; bi = tk ? ti[i] : bi; bs = tk ? i : bs; }
#pragma unroll
                for (int i = 0; i < 8; ++i) tv[i] = (i == bs) ? -INFINITY : tv[i];
                gv[k] = bv; gi[k] = bi; }
            const float e1 = __expf(gv[1] - gv[0]), e2 = __expf(gv[2] - gv[0]), e3 = __expf(gv[3] - gv[0]); const float inv = 1.0f / (1.0f + e1 + e2 + e3);
            if (half == 0) { *(int4*)(topi + (size_t)t * 4) = make_int4(gi[0], gi[1], gi[2], gi[3]); *(f32x4*)(gate + (size_t)t * 4) = (f32x4){inv, e1 * inv, e2 * inv, e3 * inv};
#pragma unroll
                for (int k = 0; k < 4; ++k) atomicAdd((unsigned*)&hist[gi[k]], 1u); }
        }
    } else {
        for (int tt = F.wave - 4; tt < TPB; tt += 4) {
            const int t = F.bid * TPB + tt; if (t >= NT) break;
            const f32x4* xr = (const f32x4*)(a.out + (size_t)t * DM) + lane; const f32x4* gr = (const f32x4*)a.norm2_g + lane;
            f32x4 hv[4]; float s = 0.f;
#pragma unroll
            for (int j = 0; j < 4; ++j) { hv[j] = xr[64 * j]; s += (hv[j].x * hv[j].x + hv[j].y * hv[j].y) + (hv[j].z * hv[j].z + hv[j].w * hv[j].w); }
            const float r = 1.0f / sqrtf(wave_sum(s) * (1.f / DM) + EPS);
            v2u* o8 = (v2u*)(h2 + (size_t)t * DM) + lane;
#pragma unroll
            for (int j = 0; j < 4; ++j) { const f32x4 g = gr[64 * j];
                if (MOE_FP8) ((unsigned*)((unsigned char*)h2 + (size_t)t * DM))[lane + 64 * j] = pk4_fp8(hv[j].x * r * g.x, hv[j].y * r * g.y, hv[j].z * r * g.z, hv[j].w * r * g.w);
                else { const bf16x4_t hb = __builtin_convertvector((f32x4){hv[j].x * r * g.x, hv[j].y * r * g.y, hv[j].z * r * g.z, hv[j].w * r * g.w}, bf16x4_t); o8[64 * j] = __builtin_bit_cast(v2u, hb); } }
        }
    }
    __syncthreads();
    if (F.tid < 32) ((int*)(a.ws + WS_BC))[F.bid * 32 + F.tid] = (int)hist[F.tid];
    __syncthreads();
}

__device__ __forceinline__ void phase5(const Args& a, const Frame& F) {
    LAS int* cnt = (LAS int*)F.lds; LAS int* base = cnt + 32; LAS int* pstart = cnt + 64; LAS unsigned* cursor = (LAS unsigned*)(cnt + 128);
    const int* BC = (const int*)(a.ws + WS_BC);
    if (F.tid < 32) { int total = 0, before = 0; for (int b = 0; b < F.G; ++b) { const int c = BC[b * 32 + F.tid]; total += c; if (b < F.bid) before += c; } cnt[F.tid] = total; base[F.tid] = before; cursor[F.tid] = 0u; }
    __syncthreads();
    if (F.tid == 0) { int ps = 0; for (int e = 0; e < 32; ++e) { pstart[e] = ps; ps += (cnt[e] + 255) & ~255; } pstart[32] = ps; }
    __syncthreads();
    const int* topi = (const int*)(a.ws + WS_TOPI); int* dest = (int*)(a.ws + WS_DEST); int* rowtok = (int*)(a.ws + WS_ROWTOK);
    const int TPB = (NT + F.G - 1) / F.G;
    LAS int* dl = cnt + 256;
    for (int i = F.tid; i < TPB * 4; i += NTHR) { const int t = F.bid * TPB + (i >> 2); int d = -1; if (t < NT) { const int e = topi[(size_t)t * 4 + (i & 3)];
        const unsigned slot = atomicAdd((unsigned*)&cursor[e], 1u); d = pstart[e] + base[e] + (int)slot; dest[(size_t)t * 4 + (i & 3)] = d; rowtok[d] = t; }
        if (i < 2048) dl[i] = d; }
    if (MOE_FP8) {
        __syncthreads();
        const unsigned char* h2b = (const unsigned char*)(a.ws + WS_XN); unsigned char* xb = (unsigned char*)(a.ws + WS_XBUF);
        const int np = (TPB * 4 < 2048) ? TPB * 4 : 2048;
        for (int tl = F.wave; tl < TPB; tl += 4 * NWAVES) {
            v4u w[4]; int dd[4][4];
#pragma unroll
            for (int q = 0; q < 4; ++q) { const int tq = tl + q * NWAVES; const int t = F.bid * TPB + (tq < TPB ? tq : tl);
                w[q] = *(const v4u*)(h2b + (size_t)t * DM + 16 * F.lane);
#pragma unroll
                for (int k = 0; k < 4; ++k) dd[q][k] = (tq < TPB && 4 * tq + k < np) ? dl[4 * tq + k] : -1; }
#pragma unroll
            for (int q = 0; q < 4; ++q)
#pragma unroll
                for (int k = 0; k < 4; ++k) if (dd[q][k] >= 0) *(v4u*)(xb + (size_t)dd[q][k] * DM + 16 * F.lane) = w[q];
        }
    }
    if (F.bid == 0) {
        const int e = F.tid >> 4; const int pe = (cnt[e] + 255) & ~255;
        for (int r = cnt[e] + (F.tid & 15); r < pe; r += 16) rowtok[pstart[e] + r] = 0;
        if (F.tid < 32) ((int*)(a.ws + WS_CNT))[F.tid] = cnt[F.tid];
    }
    __syncthreads();
}

__device__ __forceinline__ int moe_tiles(const Args& a, const Frame& F, LAS int* tstart) {
    if (F.tid == 0) { const int* cnt = (const int*)(a.ws + WS_CNT); int ts = 0; for (int e = 0; e < 32; ++e) { tstart[e] = ts; ts += (cnt[e] + 255) >> 8; } tstart[32] = ts; }
    __syncthreads();
    { LAS unsigned char* te = (LAS unsigned char*)tstart + 256; const int tm = tstart[32];
      for (int rt = F.tid; rt < tm; rt += NTHR) { int e = 0; for (int i = 1; i < 32; ++i) if (rt >= tstart[i]) e = i; te[rt] = (unsigned char)e; } }
    __syncthreads();
    return tstart[32];
}
__device__ __forceinline__ int tile_expert(const LAS int* tstart, int rt) { int e = 0;
#pragma unroll 1
    for (int i = 1; i < 32; ++i) if (rt >= tstart[i]) e = i;
    return e; }

__device__ __forceinline__ void phase6(const Args& a, const Frame& F) {
    LAS int* tstart = (LAS int*)(F.lds + 131072);
    const int TM = moe_tiles(a, F, tstart);
    const bf16* h2 = (const bf16*)(a.ws + WS_XN); const bf16* wup = (const bf16*)(a.ws + WS_WUP); bf16* act = (bf16*)(a.ws + WS_ACT); const int* rowtok = (const int*)(a.ws + WS_ROWTOK);
#if FAST_GEMM
    { constexpr int EB = MOE_FP8 ? 1 : 2;
      pg8::EpiSwiglu E{act, a.b_up, (const LAS unsigned char*)tstart + 256};
      if constexpr (MOE_FP8) { pg8::MoeSched<false> S{a.ws + WS_XBUF, wup, rowtok, tstart, TM, DUP / 256, F.G, F.bid, DM * EB, (size_t)DUP * DM * EB};
          pg8::gemm_phase<pg8::EpiSwiglu, pg8::MoeSched<false>, true, true>(F.lds, DM * EB, S, E, a.ws, a.li == 1); }
      else { pg8::MoeSched<true> S{h2, wup, rowtok, tstart, TM, DUP / 256, F.G, F.bid, DM * EB, (size_t)DUP * DM * EB};
          pg8::gemm_phase<pg8::EpiSwiglu, pg8::MoeSched<true>, true, false>(F.lds, DM * EB, S, E, a.ws); }
      return; }
#endif
    constexpr int NPN = DUP / 128; const int NU = TM * NPN;
    for (int u = F.bid; u < NU; u += F.G) {
        const int rt = u / NPN, pn = u % NPN; const int e = tile_expert(tstart, rt);
        const int* rtk = rowtok + (size_t)rt * 256;
        auto rp = [&](int r) { return h2 + (size_t)rtk[r] * DM; };
        const float* bias = a.b_up + (size_t)e * DUP + pn * 128; bf16* O = act + (size_t)rt * 256 * DEXP + pn * 64;
        auto epi = [&](int r, int c, const f32x4& v) { const f32x4 bv = *(const f32x4*)(bias + c);
            const float g0 = fminf(v.x + bv.x, 7.0f), l0 = fminf(fmaxf(v.y + bv.y, -7.0f), 7.0f), g1 = fminf(v.z + bv.z, 7.0f), l1 = fminf(fmaxf(v.w + bv.w, -7.0f), 7.0f);
            const float a0 = g0 / (1.0f + __expf(-1.702f * g0)) * (l0 + 1.0f), a1 = g1 / (1.0f + __expf(-1.702f * g1)) * (l1 + 1.0f);
            *(unsigned*)(O + (size_t)r * DEXP + (c >> 1)) = pk2(a0, a1); };
        gemm_unit_simple(rp, wup + (size_t)e * DUP * DM + (size_t)pn * 128 * DM, DM, epi, F.wave, F.lane);
    }
}

__device__ __forceinline__ void phase7(const Args& a, const Frame& F) {
    LAS int* tstart = (LAS int*)(F.lds + 131072);
    const int TM = moe_tiles(a, F, tstart);
    const bf16* act = (const bf16*)(a.ws + WS_ACT); const bf16* wdn = (const bf16*)(a.ws + WS_WDN); bf16* yb = (bf16*)(a.ws + WS_YBUF);
#if FAST_GEMM
    { constexpr int EB = MOE_FP8 ? 1 : 2;
      pg8::MoeSched<false> S{act, wdn, nullptr, tstart, TM, DM / 256, F.G, F.bid, DEXP * EB, (size_t)DM * DEXP * EB}; pg8::EpiY E{yb, a.b_down, (const LAS unsigned char*)tstart + 256};
      pg8::gemm_phase<pg8::EpiY, pg8::MoeSched<false>, true, MOE_FP8>(F.lds, DEXP * EB, S, E, a.ws, a.li == 1); return; }
#endif
    constexpr int NPN = DM / 128; const int NU = TM * NPN;
    for (int u = F.bid; u < NU; u += F.G) {
        const int rt = u / NPN, pn = u % NPN; const int e = tile_expert(tstart, rt);
        const bf16* A0 = act + (size_t)rt * 256 * DEXP;
        auto rp = [&](int r) { return A0 + (size_t)r * DEXP; };
        const float* bias = a.b_down + (size_t)e * DM + pn * 128; bf16* O = yb + (size_t)rt * 256 * DM + pn * 128;
        auto epi = [&](int r, int c, const f32x4& v) { const f32x4 bv = *(const f32x4*)(bias + c); v2u w; w.x = pk2(v.x + bv.x, v.y + bv.y); w.y = pk2(v.z + bv.z, v.w + bv.w); *(v2u*)(O + (size_t)r * DM + c) = w; };
        gemm_unit_simple(rp, wdn + (size_t)e * DM * DEXP + (size_t)pn * 128 * DEXP, DEXP, epi, F.wave, F.lane);
    }
}

__device__ __forceinline__ void phase8(const Args& a, const Frame& F) {
    const bf16* yb = (const bf16*)(a.ws + WS_YBUF); const int* dest = (const int*)(a.ws + WS_DEST); const float* gate = (const float*)(a.ws + WS_GATE);
    const int gw = F.bid * NWAVES + F.wave, NGW = F.G * NWAVES, lane = F.lane;
    const f32x4* gr = (const f32x4*)a.final_g + lane;
    f32x4 fg[4];
#pragma unroll
    for (int j = 0; j < 4; ++j) fg[j] = gr[64 * j];
    for (int t = gw; t < NT; t += 2 * NGW) {
        const int t2 = (t + NGW < NT) ? t + NGW : t;
        f32x4* xr = (f32x4*)(a.out + (size_t)t * DM) + lane; f32x4* xr2 = (f32x4*)(a.out + (size_t)t2 * DM) + lane;
        const int4 d4 = *(const int4*)(dest + (size_t)t * 4), e4 = *(const int4*)(dest + (size_t)t2 * 4); const f32x4 g4 = *(const f32x4*)(gate + (size_t)t * 4), h4 = *(const f32x4*)(gate + (size_t)t2 * 4);
        f32x4 v[4], u[4];
#pragma unroll
        for (int j = 0; j < 4; ++j) { v[j] = xr[64 * j]; u[j] = xr2[64 * j]; }
        v2u yv[4][4], yu[4][4];
#pragma unroll
        for (int k = 0; k < 4; ++k) { const int d = k == 0 ? d4.x : k == 1 ? d4.y : k == 2 ? d4.z : d4.w; const int e = k == 0 ? e4.x : k == 1 ? e4.y : k == 2 ? e4.z : e4.w;
            const v2u* yr = (const v2u*)(yb + (size_t)d * DM) + lane; const v2u* yr2 = (const v2u*)(yb + (size_t)e * DM) + lane;
#pragma unroll
            for (int j = 0; j < 4; ++j) { yv[k][j] = yr[64 * j]; yu[k][j] = yr2[64 * j]; } }
#pragma unroll
        for (int k = 0; k < 4; ++k) { const float g = k == 0 ? g4.x : k == 1 ? g4.y : k == 2 ? g4.z : g4.w; const float hq = k == 0 ? h4.x : k == 1 ? h4.y : k == 2 ? h4.z : h4.w;
#pragma unroll
            for (int j = 0; j < 4; ++j) { const v2u w = yv[k][j]; v[j].x += g * bflo(w.x); v[j].y += g * bfhi(w.x); v[j].z += g * bflo(w.y); v[j].w += g * bfhi(w.y);
                const v2u w2 = yu[k][j]; u[j].x += hq * bflo(w2.x); u[j].y += hq * bfhi(w2.x); u[j].z += hq * bflo(w2.y); u[j].w += hq * bfhi(w2.y); } }
        float s = 0.f, s2 = 0.f;
#pragma unroll
        for (int j = 0; j < 4; ++j) { s += (v[j].x * v[j].x + v[j].y * v[j].y) + (v[j].z * v[j].z + v[j].w * v[j].w); s2 += (u[j].x * u[j].x + u[j].y * u[j].y) + (u[j].z * u[j].z + u[j].w * u[j].w); }
        const float r = 1.0f / sqrtf(wave_sum(s) * (1.f / DM) + EPS), r2 = 1.0f / sqrtf(wave_sum(s2) * (1.f / DM) + EPS);
#pragma unroll
        for (int j = 0; j < 4; ++j) { const f32x4 g = fg[j]; xr[64 * j] = (f32x4){v[j].x * r * g.x, v[j].y * r * g.y, v[j].z * r * g.z, v[j].w * r * g.w};
            if (t2 != t) xr2[64 * j] = (f32x4){u[j].x * r2 * g.x, u[j].y * r2 * g.y, u[j].z * r2 * g.z, u[j].w * r2 * g.w}; }
    }
}

__global__ void __launch_bounds__(NTHR, 2) fwd(Args args) {
    extern __shared__ __attribute__((aligned(16))) unsigned char lds[];
    Frame F0; F0.lds = (LAS unsigned char*)lds; F0.tid = threadIdx.x; F0.lane = F0.tid & 63; F0.wave = __builtin_amdgcn_readfirstlane(F0.tid >> 6); F0.G = gridDim.x; F0.bid = blockIdx.x; const Frame& F = F0;
    volatile LAS unsigned* MISC = (volatile LAS unsigned*)(F.lds + MISC_OFF);
    if (F.tid < 32) MISC[F.tid] = 0u;
    __syncthreads();
    XcdBarrier bar; bar.bar = (unsigned*)(args.ws + WS_CTL) + CW_BAR + args.li * XCD_BAR_WORDS; bar.x = 0; bar.st = nullptr;
    if (MK_N_LAUNCHES == 1) bar = xcd_barrier_post((unsigned*)(args.ws + WS_CTL) + CW_BAR + args.li * XCD_BAR_WORDS, MISC + 8);
    const int lo = args.ph_lo, hi = args.ph_hi;
#define IN(k) (lo <= (k) && (k) < hi)
#define SEAM(k) do { if (IN(k) && IN((k) + 1)) xcd_barrier(bar); } while (0)
#ifndef DBL
#define DBL 0
#endif
#define REP(k) for (int rep_ = 0; rep_ < (((DBL) >> (k)) & 1) + 1; ++rep_)
#define FR() ({ Frame f_ = F0; int t_ = threadIdx.x; asm volatile("" : "+v"(t_)); f_.tid = t_; f_.lane = t_ & 63; f_; })
    if (IN(0)) REP(0) { phase0(args, FR()); if (rep_ == 0 && ((DBL >> 0) & 1)) xcd_barrier(bar); } SEAM(0);
    if (IN(1)) REP(1) { phase1(args, FR()); if (rep_ == 0 && ((DBL >> 1) & 1)) xcd_barrier(bar); } SEAM(1);
    if (IN(2)) REP(2) { phase2(args, FR()); if (rep_ == 0 && ((DBL >> 2) & 1)) xcd_barrier(bar); } SEAM(2);
    if (IN(3)) REP(3) { phase2b(args, FR()); if (rep_ == 0 && ((DBL >> 3) & 1)) xcd_barrier(bar); } SEAM(3);
    if (IN(4)) REP(4) { phase3(args, FR()); if (rep_ == 0 && ((DBL >> 4) & 1)) xcd_barrier(bar); } SEAM(4);
    if (IN(5)) REP(5) { phase4_mfma(args, FR()); if (rep_ == 0 && ((DBL >> 5) & 1)) xcd_barrier(bar); } SEAM(5);
    if (IN(6)) REP(6) { phase5(args, FR()); if (rep_ == 0 && ((DBL >> 6) & 1)) xcd_barrier(bar); } SEAM(6);
    if (IN(7)) REP(7) { phase6(args, FR()); if (rep_ == 0 && ((DBL >> 7) & 1)) xcd_barrier(bar); } SEAM(7);
    if (IN(8)) REP(8) { phase7(args, FR()); if (rep_ == 0 && ((DBL >> 8) & 1)) xcd_barrier(bar); } SEAM(8);
    if (IN(9)) phase8(args, FR());
#undef IN
#undef SEAM
}

extern "C" void kernel_launch(void* const* d_in, const int* in_sizes, int n_in, void* d_out, int out_size, void* d_ws, size_t ws_size, hipStream_t stream) {
    static int grid = 0;
    if (grid == 0) {
        if (n_in != 15 || in_sizes[0] != NT * DM || out_size != NT * DM || ws_size < WS_END) { fprintf(stderr, "kernel_launch: shape/workspace mismatch (n_in %d, in0 %d, out %d, ws %zu)\n", n_in, n_in > 0 ? in_sizes[0] : -1, out_size, ws_size); grid = -1; return; }
        int dev = 0, cus = 0;
        if (hipGetDevice(&dev) != hipSuccess || hipDeviceGetAttribute(&cus, hipDeviceAttributeMultiprocessorCount, dev) != hipSuccess) { grid = -1; return; }
        if (hipFuncSetAttribute((const void*)fwd, hipFuncAttributeMaxDynamicSharedMemorySize, LDS_BYTES) != hipSuccess) { fprintf(stderr, "kernel_launch: hipFuncSetAttribute failed\n"); grid = -1; return; }
        int per_cu = 0;
        if (hipOccupancyMaxActiveBlocksPerMultiprocessor(&per_cu, (const void*)fwd, NTHR, LDS_BYTES) != hipSuccess || per_cu < 1) fprintf(stderr, "kernel_launch: occupancy query reports %d\n", per_cu);
        (void)hipGetLastError();
        grid = cus;
    }
    if (grid < 0) return;
    (void)hipMemsetAsync((char*)d_ws + WS_CTL, 0, CTL_ZERO_BYTES, stream);
    Args a{};
    a.x = (const float*)d_in[0]; a.norm1_g = (const float*)d_in[1]; a.w_in = (const float*)d_in[2]; a.lb_logits = (const float*)d_in[3]; a.hgrn_g = (const float*)d_in[4]; a.attn_g = (const float*)d_in[5];
    a.w_out = (const float*)d_in[6]; a.norm2_g = (const float*)d_in[7]; a.router_w = (const float*)d_in[8]; a.router_b = (const float*)d_in[9]; a.w_up = (const float*)d_in[10]; a.b_up = (const float*)d_in[11];
    a.w_down = (const float*)d_in[12]; a.b_down = (const float*)d_in[13]; a.final_g = (const float*)d_in[14];
    a.out = (float*)d_out; a.ws = (unsigned char*)d_ws;
#ifndef PROBE_PH
#define PROBE_PH -1
#endif
    if (PROBE_PH >= 0) {
        a.ph_lo = 0; a.ph_hi = PROBE_PH + 1; a.li = 0; hipLaunchKernelGGL(fwd, dim3(grid), dim3(NTHR), LDS_BYTES, stream, a);
        a.ph_lo = PROBE_PH; a.ph_hi = PROBE_PH + 1; a.li = 1; hipLaunchKernelGGL(fwd, dim3(grid), dim3(NTHR), LDS_BYTES, stream, a);
        a.ph_lo = PROBE_PH + 1; a.ph_hi = NPHASE; a.li = 2; hipLaunchKernelGGL(fwd, dim3(grid), dim3(NTHR), LDS_BYTES, stream, a);
    } else
    if (MK_N_LAUNCHES == 1) { a.ph_lo = 0; a.ph_hi = NPHASE; hipLaunchKernelGGL(fwd, dim3(grid), dim3(NTHR), LDS_BYTES, stream, a); }
    else for (int p = 0; p < NPHASE; ++p) { a.ph_lo = p; a.ph_hi = p + 1; hipLaunchKernelGGL(fwd, dim3(grid), dim3(NTHR), LDS_BYTES, stream, a); }
}
```
